# Optimizing an MI355X kernel written in HIP

```python
import math, functools
import jax, jax.numpy as jnp
from jax import lax
import numpy as np

D_MODEL = 2048
BATCH = 2
SEQ = 8192
DEPTH = 2

GRID_W = 64
CTX_LEN = 256
HEAD_DIM = 64
ROPE_THETA = 10000.0
NORM_EPS = 1e-6
NEG_INF = -1e30

CONV_CH = D_MODEL // 4
CONV_K = 31
DIFF_HEADS = (3 * D_MODEL // 8) // (2 * HEAD_DIM)
DIFF_V_DIM = 2 * HEAD_DIM
SWA_Q_HEADS = (3 * D_MODEL // 8) // HEAD_DIM
SWA_KV_HEADS = SWA_Q_HEADS // 3
SWA_GROUP = SWA_Q_HEADS // SWA_KV_HEADS
WINDOW = 128
BLOCK = 128

D_MIX = CONV_CH + DIFF_HEADS * DIFF_V_DIM + SWA_Q_HEADS * HEAD_DIM

IN_A = 2 * CONV_CH
IN_BQ = 2 * DIFF_HEADS * HEAD_DIM
IN_CQ = SWA_Q_HEADS * HEAD_DIM
IN_BK = 2 * DIFF_HEADS * HEAD_DIM
IN_BV = DIFF_HEADS * DIFF_V_DIM
IN_CK = SWA_KV_HEADS * HEAD_DIM
IN_CV = SWA_KV_HEADS * HEAD_DIM
OFF_Q = IN_A
OFF_KV = IN_A + IN_BQ + IN_CQ
D_IN = OFF_KV + IN_BK + IN_BV + IN_CK + IN_CV

D_FF = 5632
N_EXPERTS = 8
TOP_K = 2
N_DENSE = (DEPTH + 1) // 2
N_MOE = DEPTH // 2

kernel_name = "hybrid_dit_conv_diffattn_swa_moe"


def rmsnorm(x, g):
    xf = x.astype(jnp.float32)
    y = xf * lax.rsqrt(jnp.mean(xf * xf, axis=-1, keepdims=True) + NORM_EPS)
    return (y * g.astype(jnp.float32)).astype(x.dtype)


def layernorm(x, g, b):
    xf = x.astype(jnp.float32)
    mu = jnp.mean(xf, axis=-1, keepdims=True)
    var = jnp.mean(jnp.square(xf - mu), axis=-1, keepdims=True)
    y = (xf - mu) * lax.rsqrt(var + NORM_EPS)
    return (y * g.astype(jnp.float32) + b.astype(jnp.float32)).astype(x.dtype)


def modulate(h, shift, scale):
    return h * (1 + scale) + shift


def rope_tables(n_tokens):
    rows = n_tokens // GRID_W
    row = jnp.repeat(jnp.arange(rows), GRID_W).astype(jnp.float32)
    col = jnp.tile(jnp.arange(GRID_W), rows).astype(jnp.float32)
    axis_dim = HEAD_DIM // 2
    inv = ROPE_THETA ** (-jnp.arange(axis_dim // 2, dtype=jnp.float32) / (axis_dim // 2))
    ang_r = row[:, None] * inv[None, :]
    ang_c = col[:, None] * inv[None, :]
    ang = jnp.concatenate([ang_r, ang_r, ang_c, ang_c], axis=-1)
    return jnp.cos(ang), jnp.sin(ang)


def apply_rope(x, cos, sin):
    shp = (cos.shape[0],) + (1,) * (x.ndim - 3) + (HEAD_DIM,)
    cos, sin = cos.reshape(shp), sin.reshape(shp)
    xr = x.reshape(x.shape[:-1] + (2, 2, HEAD_DIM // 4))
    rot = jnp.stack([-xr[..., 1, :], xr[..., 0, :]], axis=-2).reshape(x.shape)
    return (x * cos + rot * sin).astype(x.dtype)


def split_q(u):
    B, L = u.shape[:2]
    bq = u[..., :IN_BQ].reshape(B, L, DIFF_HEADS, 2, HEAD_DIM)
    cq = u[..., IN_BQ:].reshape(B, L, SWA_KV_HEADS, SWA_GROUP, HEAD_DIM)
    return bq, cq


def split_kv(u):
    B, L = u.shape[:2]
    o1 = IN_BK
    o2 = o1 + IN_BV
    o3 = o2 + IN_CK
    bk = u[..., :o1].reshape(B, L, DIFF_HEADS, 2, HEAD_DIM)
    bv = u[..., o1:o2].reshape(B, L, DIFF_HEADS, DIFF_V_DIM)
    ck = u[..., o2:o3].reshape(B, L, SWA_KV_HEADS, HEAD_DIM)
    cv = u[..., o3:].reshape(B, L, SWA_KV_HEADS, HEAD_DIM)
    return bk, bv, ck, cv


def conv_module(u, w_dw, b_dw, ln_g, ln_b):
    a, g = jnp.split(u, 2, axis=-1)
    y = a * jax.nn.sigmoid(g)
    y = lax.conv_general_dilated(y, w_dw, window_strides=(1,), padding=((CONV_K // 2, CONV_K // 2),),
                                 dimension_numbers=("NWC", "WIO", "NWC"), feature_group_count=CONV_CH)
    y = layernorm(y + b_dw, ln_g, ln_b)
    return jax.nn.silu(y)


def diff_attend(q, k, v, lam):
    s = jnp.einsum("bqhcd,bkhcd->bhcqk", q, k).astype(jnp.float32) * (HEAD_DIM ** -0.5)
    p = jax.nn.softmax(s, axis=-1)
    a = p[:, :, 0] - lam * p[:, :, 1]
    return jnp.einsum("bhqk,bkhe->bqhe", a.astype(v.dtype), v)


def diff_attention_latent(q, k_all, v_all, lam):
    B, N = q.shape[:2]
    nb = N // BLOCK
    qb = jnp.moveaxis(q.reshape((B, nb, BLOCK) + q.shape[2:]), 1, 0)
    out = lax.map(lambda qblk: diff_attend(qblk, k_all, v_all, lam), qb)
    return jnp.moveaxis(out, 0, 1).reshape(B, N, DIFF_HEADS, DIFF_V_DIM)


def diff_head_out(o, g_subln, lam_init):
    B, L = o.shape[:2]
    return (rmsnorm(o, g_subln) * (1.0 - lam_init)).reshape(B, L, DIFF_HEADS * DIFF_V_DIM)


def swa_latent(q, k, v, kc, vc, sink):
    B, N = q.shape[:2]
    nb = N // BLOCK
    qb = q.reshape(B, nb, BLOCK, SWA_KV_HEADS, SWA_GROUP, HEAD_DIM)

    def band(t):
        tb = t.reshape(B, nb, BLOCK, SWA_KV_HEADS, HEAD_DIM)
        tp = jnp.pad(tb, ((0, 0), (1, 1), (0, 0), (0, 0), (0, 0)))
        return jnp.concatenate([tp[:, :-2], tp[:, 1:-1], tp[:, 2:]], axis=2)

    kb, vb = band(k), band(v)
    scale = HEAD_DIM ** -0.5
    s_loc = jnp.einsum("bnqhgd,bnjhd->bnhgqj", qb, kb).astype(jnp.float32) * scale
    blk = jnp.arange(nb)[:, None, None]
    qpos = blk * BLOCK + jnp.arange(BLOCK)[None, :, None]
    kpos = (blk - 1) * BLOCK + jnp.arange(3 * BLOCK)[None, None, :]
    valid = (jnp.abs(qpos - kpos) <= WINDOW) & (kpos >= 0) & (kpos < N)
    s_loc = jnp.where(valid[None, :, None, None], s_loc, NEG_INF)
    s_ctx = jnp.einsum("bnqhgd,bjhd->bnhgqj", qb, kc).astype(jnp.float32) * scale
    sink_col = jnp.broadcast_to(sink.astype(jnp.float32).reshape(SWA_KV_HEADS, SWA_GROUP, 1, 1),
                                s_loc.shape[:-1] + (1,))
    p = jax.nn.softmax(jnp.concatenate([s_ctx, s_loc, sink_col], axis=-1), axis=-1)
    lc = kc.shape[1]
    pc = p[..., :lc].astype(vc.dtype)
    pl = p[..., lc:lc + 3 * BLOCK].astype(vb.dtype)
    out = jnp.einsum("bnhgqj,bjhd->bnqhgd", pc, vc) + jnp.einsum("bnhgqj,bnjhd->bnqhgd", pl, vb)
    return out.reshape(B, N, SWA_Q_HEADS * HEAD_DIM)


def swa_context(q, kc, vc, sink):
    B, L = q.shape[:2]
    s = jnp.einsum("bqhgd,bjhd->bhgqj", q, kc).astype(jnp.float32) * (HEAD_DIM ** -0.5)
    sink_col = jnp.broadcast_to(sink.astype(jnp.float32).reshape(SWA_KV_HEADS, SWA_GROUP, 1, 1),
                                s.shape[:-1] + (1,))
    p = jax.nn.softmax(jnp.concatenate([s, sink_col], axis=-1), axis=-1)[..., :-1]
    out = jnp.einsum("bhgqj,bjhd->bqhgd", p.astype(vc.dtype), vc)
    return out.reshape(B, L, SWA_Q_HEADS * HEAD_DIM)


def swiglu(h, w_gate, w_up, w_down):
    return (jax.nn.silu(h @ w_gate) * (h @ w_up)) @ w_down


def moe_swiglu(h, w_router, w_gate, w_up, w_down):
    logits = (h @ w_router).astype(jnp.float32)
    top_v, top_i = lax.top_k(logits, TOP_K)
    top_w = jax.nn.softmax(top_v, axis=-1)
    gates = jnp.sum(jax.nn.one_hot(top_i, N_EXPERTS, dtype=jnp.float32) * top_w[..., None], axis=-2).astype(h.dtype)
    out = jnp.zeros_like(h)
    for e in range(N_EXPERTS):
        out = out + gates[..., e:e + 1] * swiglu(h, w_gate[e], w_up[e], w_down[e])
    return out


def trunk_layer(xl, xc, c, c_ctx, w_ada, b_ada, g_n1, g_n2, w_in, w_dw, b_dw, ln_g, ln_b,
                lam_q1, lam_k1, lam_q2, lam_k2, g_subln, sink, w_out, ffn, lam_init, update_ctx):
    sh1_l, sc1_l, gt1_l, sh2_l, sc2_l, gt2_l = jnp.split((jax.nn.silu(c) @ w_ada + b_ada)[:, None, :], 6, axis=-1)
    sh1_c, sc1_c, gt1_c, sh2_c, sc2_c, gt2_c = jnp.split((jax.nn.silu(c_ctx) @ w_ada + b_ada)[None, :], 6, axis=-1)
    f32 = jnp.float32
    lam = (jnp.exp(jnp.sum(lam_q1.astype(f32) * lam_k1.astype(f32)))
           - jnp.exp(jnp.sum(lam_q2.astype(f32) * lam_k2.astype(f32))) + lam_init)

    hc = modulate(rmsnorm(xc, g_n1), sh1_c, sc1_c)
    if update_ctx:
        uc = hc @ w_in
        ukv_c = uc[..., OFF_KV:]
    else:
        ukv_c = hc @ w_in[:, OFF_KV:]
    bk_c, bv_c, ck_c, cv_c = split_kv(ukv_c)

    hl = modulate(rmsnorm(xl, g_n1), sh1_l, sc1_l)
    ul = hl @ w_in
    cos, sin = rope_tables(xl.shape[1])
    a_l = conv_module(ul[..., :IN_A], w_dw, b_dw, ln_g, ln_b)
    bq_l, cq_l = split_q(ul[..., OFF_Q:OFF_KV])
    bk_l, bv_l, ck_l, cv_l = split_kv(ul[..., OFF_KV:])
    bq_l, bk_l = apply_rope(bq_l, cos, sin), apply_rope(bk_l, cos, sin)
    cq_l, ck_l = apply_rope(cq_l, cos, sin), apply_rope(ck_l, cos, sin)
    o_b = diff_attention_latent(bq_l, jnp.concatenate([bk_c, bk_l], axis=1),
                                jnp.concatenate([bv_c, bv_l], axis=1), lam)
    o_c = swa_latent(cq_l, ck_l, cv_l, ck_c, cv_c, sink)
    mix_l = jnp.concatenate([a_l, diff_head_out(o_b, g_subln, lam_init), o_c], axis=-1) @ w_out
    xl = xl + gt1_l * mix_l
    hl2 = modulate(rmsnorm(xl, g_n2), sh2_l, sc2_l)

    if update_ctx:
        a_c = conv_module(uc[..., :IN_A], w_dw, b_dw, ln_g, ln_b)
        bq_c, cq_c = split_q(uc[..., OFF_Q:OFF_KV])
        o_bc = diff_attend(bq_c, bk_c, bv_c, lam)
        o_cc = swa_context(cq_c, ck_c, cv_c, sink)
        mix_c = jnp.concatenate([a_c, diff_head_out(o_bc, g_subln, lam_init), o_cc], axis=-1) @ w_out
        xc = xc + gt1_c * mix_c
        hc2 = modulate(rmsnorm(xc, g_n2), sh2_c, sc2_c)
        lc = xc.shape[1]
        f = ffn(jnp.concatenate([hc2, hl2], axis=1))
        xc = xc + gt2_c * f[:, :lc]
        xl = xl + gt2_l * f[:, lc:]
        return xl, xc
    xl = xl + gt2_l * ffn(hl2)
    return xl, None


def setup_inputs(seed: int = 0) -> dict:
    key = jax.random.key(seed)
    ks = jax.random.split(key, 32)
    D = D_MODEL

    def nrm(k, shape, scale):
        return jax.random.normal(k, shape, jnp.float32) * scale

    return {
        "x": nrm(ks[0], (BATCH, SEQ, D), 1.0),
        "c": nrm(ks[1], (BATCH, D), 1.0),
        "ctx": nrm(ks[2], (BATCH, CTX_LEN, D), 1.0),
        "c_ctx": nrm(ks[3], (D,), 1.0),
        "w_ada": nrm(ks[4], (DEPTH, D, 6 * D), 0.5 * D ** -0.5),
        "b_ada": nrm(ks[5], (DEPTH, 6 * D), 0.02),
        "g_norm1": 1.0 + nrm(ks[6], (DEPTH, D), 0.1),
        "g_norm2": 1.0 + nrm(ks[7], (DEPTH, D), 0.1),
        "w_in": nrm(ks[8], (DEPTH, D, D_IN), D ** -0.5),
        "w_dw": nrm(ks[9], (DEPTH, CONV_K, 1, CONV_CH), CONV_K ** -0.5),
        "b_dw": nrm(ks[10], (DEPTH, CONV_CH), 0.02),
        "ln_g": 1.0 + nrm(ks[11], (DEPTH, CONV_CH), 0.1),
        "ln_b": nrm(ks[12], (DEPTH, CONV_CH), 0.02),
        "lam_q1": nrm(ks[13], (DEPTH, HEAD_DIM), 0.1),
        "lam_k1": nrm(ks[14], (DEPTH, HEAD_DIM), 0.1),
        "lam_q2": nrm(ks[15], (DEPTH, HEAD_DIM), 0.1),
        "lam_k2": nrm(ks[16], (DEPTH, HEAD_DIM), 0.1),
        "g_subln": 1.0 + nrm(ks[17], (DEPTH, DIFF_V_DIM), 0.1),
        "sink": nrm(ks[18], (DEPTH, SWA_Q_HEADS), 0.5),
        "w_out": nrm(ks[19], (DEPTH, D_MIX, D), D_MIX ** -0.5),
        "w_ff_gate": nrm(ks[20], (N_DENSE, D, D_FF), D ** -0.5),
        "w_ff_up": nrm(ks[21], (N_DENSE, D, D_FF), D ** -0.5),
        "w_ff_down": nrm(ks[22], (N_DENSE, D_FF, D), D_FF ** -0.5),
        "w_router": nrm(ks[23], (N_MOE, D, N_EXPERTS), D ** -0.5),
        "w_ex_gate": nrm(ks[24], (N_MOE, N_EXPERTS, D, D_FF), D ** -0.5),
        "w_ex_up": nrm(ks[25], (N_MOE, N_EXPERTS, D, D_FF), D ** -0.5),
        "w_ex_down": nrm(ks[26], (N_MOE, N_EXPERTS, D_FF, D), D_FF ** -0.5),
        "g_final": 1.0 + nrm(ks[27], (D,), 0.1),
    }


def reference(x, c, ctx, c_ctx, w_ada, b_ada, g_norm1, g_norm2, w_in, w_dw, b_dw, ln_g, ln_b,
              lam_q1, lam_k1, lam_q2, lam_k2, g_subln, sink, w_out, w_ff_gate, w_ff_up, w_ff_down,
              w_router, w_ex_gate, w_ex_up, w_ex_down, g_final):
    xl, xc = x, ctx
    for l in range(DEPTH):
        i = l // 2
        if l % 2 == 0:
            ffn = functools.partial(swiglu, w_gate=w_ff_gate[i], w_up=w_ff_up[i], w_down=w_ff_down[i])
        else:
            ffn = functools.partial(moe_swiglu, w_router=w_router[i], w_gate=w_ex_gate[i],
                                    w_up=w_ex_up[i], w_down=w_ex_down[i])
        lam_init = 0.8 - 0.6 * math.exp(-0.3 * l)
        xl, xc = trunk_layer(xl, xc, c, c_ctx, w_ada[l], b_ada[l], g_norm1[l], g_norm2[l], w_in[l],
                             w_dw[l], b_dw[l], ln_g[l], ln_b[l], lam_q1[l], lam_k1[l], lam_q2[l], lam_k2[l],
                             g_subln[l], sink[l], w_out[l], ffn, lam_init, l < DEPTH - 1)
    return rmsnorm(xl, g_final)
```

```cpp
#include <hip/hip_runtime.h>
#include <cstdio>
#include <cstdint>

#ifndef PROBE_DUP
#define PROBE_DUP (-1)
#endif
#ifndef PROBE_EPI2
#define PROBE_EPI2 0
#endif
#ifndef MK_MULTI
#define MK_MULTI 0
#endif

#define LAS __attribute__((address_space(3)))
#define GAS __attribute__((address_space(1)))
typedef unsigned short bf16_t;
typedef short bf16x8 __attribute__((ext_vector_type(8)));
typedef short s16x4 __attribute__((ext_vector_type(4)));
typedef float f32x2 __attribute__((ext_vector_type(2)));
typedef float f32x4 __attribute__((ext_vector_type(4)));
typedef float f32x16 __attribute__((ext_vector_type(16)));
typedef unsigned u32x2 __attribute__((ext_vector_type(2)));
typedef unsigned u32x4 __attribute__((ext_vector_type(4)));
typedef __bf16 bf16x2_t __attribute__((ext_vector_type(2)));
typedef int i32x4 __attribute__((ext_vector_type(4)));
typedef int i32x8 __attribute__((ext_vector_type(8)));

constexpr int DM = 2048, SEQ = 8192, CTXL = 256, NBATCH = 2, SEG = SEQ + CTXL, MALL = NBATCH * SEG, NTOK = NBATCH * SEQ;
constexpr int DIN = 4608, DFF = 5632, NEXP = 8;
constexpr int OFF_Q = 1024, OFF_CQ = 1792, OFF_KV = 2560, OFF_BV = 3328, OFF_CK = 4096, OFF_CV = 4352;
constexpr int MIX_DIFF = 512, MIX_SWA = 1280;
constexpr int UROWB = DIN * 2;
constexpr int Q8_OFF = 2048, QB_Q = 0, QB_CQ = 768, QB_K = 1536, QB_CK = 2304;
constexpr int ADA_N = 6 * DM;
constexpr int MOE_ROWS = NTOK * 2 + NEXP * 256;
constexpr int MOE_TILES_MAX = MOE_ROWS / 256;
constexpr float NORM_EPS = 1e-6f;

constexpr size_t MiB = 1u << 20;
constexpr size_t WS_CTL = 0, WS_RMX = 64 * 1024, CTL_ZERO_BYTES = 256 * 1024;
constexpr size_t WS_ADA = 1 * MiB;
constexpr size_t WS_ROPE = WS_ADA + 2 * 3 * ADA_N * 4;
constexpr size_t WS_LAM = WS_ROPE + 2 * 128 * 16 * 4;
constexpr size_t WS_CCNT = WS_LAM + 256;
constexpr size_t WS_TOKE = WS_CCNT + 256 * 8 * 4;
constexpr size_t WS_TOKW = WS_TOKE + NTOK * 4;
constexpr size_t WS_TOKP = WS_TOKW + NTOK * 8;
constexpr size_t WS_HSC = WS_TOKP + NTOK * 8;
constexpr size_t WS_HSS = WS_HSC + MALL * 4;
constexpr size_t WS_WSC1 = WS_HSS + MOE_ROWS * 4;
constexpr size_t WS_WSCX = WS_WSC1 + 2 * DFF * 4;
constexpr size_t WS_WSCIN = WS_WSCX + NEXP * 2 * DFF * 4;
constexpr size_t WS_WSCD = WS_WSCIN + 2 * DIN * 4;
constexpr size_t WS_HQS = WS_WSCD + 9 * DM * 4;
constexpr size_t WS_WSCO = WS_HQS + MOE_ROWS * 4;
constexpr size_t WS_MXS = WS_WSCO + 2 * DM * 4;
constexpr size_t WS_SMALL_END = WS_MXS + MALL * 4;
static_assert(WS_SMALL_END <= 4 * MiB && WS_RMX + MOE_ROWS * 4 <= CTL_ZERO_BYTES, "small tables");
constexpr size_t SZ_WIN = (size_t)DIN * DM * 2, SZ_WOUT = (size_t)DM * DM * 2, SZ_FF1 = (size_t)2 * DFF * DM * 2, SZ_FF2 = (size_t)DM * DFF * 2;
constexpr size_t WS_WIN = 4 * MiB;
constexpr size_t WS_WOUT = WS_WIN + 2 * SZ_WIN;
constexpr size_t WS_FF1 = WS_WOUT + 2 * SZ_WOUT;
constexpr size_t WS_FF2 = WS_FF1 + SZ_FF1;
constexpr size_t WS_EX1 = WS_FF2 + SZ_FF2;
constexpr size_t WS_EX2 = WS_EX1 + NEXP * SZ_FF1;
constexpr size_t WS_H = WS_EX2 + NEXP * SZ_FF2;
constexpr size_t WS_U = WS_H + (size_t)MALL * DM * 2;
constexpr size_t WS_OC = WS_U + (size_t)MALL * DIN * 2;
constexpr size_t WS_MIX = WS_OC + (size_t)2 * MALL * 768 * 4;
constexpr size_t WS_XL = WS_MIX + (size_t)MALL * DM * 2;
constexpr size_t WS_HMID = WS_XL + (size_t)MALL * DM * 4;
constexpr size_t WS_VT8 = WS_HMID + (size_t)MOE_ROWS * DFF;
constexpr size_t WS_END = WS_HMID + (size_t)MOE_ROWS * DFF * 2;
static_assert(WS_VT8 + (size_t)NBATCH * 1024 * SEG <= WS_END, "Vt8 fits");
constexpr size_t WS_HS = WS_U, WS_Y = WS_OC;
static_assert((size_t)MOE_ROWS * DM * 2 <= (size_t)MALL * DIN * 2, "HS fits in U");
static_assert((size_t)MOE_ROWS * DM * 2 <= WS_XL - WS_OC, "Y fits in OC+MIX");

constexpr int LDS_BYTES = 147456;
constexpr int MISC_OFF = 139264;
constexpr int NWAVES = 8;

__device__ __forceinline__ unsigned cvtpk(float lo, float hi) { f32x2 v = {lo, hi}; bf16x2_t b = __builtin_convertvector(v, bf16x2_t); return __builtin_bit_cast(unsigned, b); }
__device__ __forceinline__ float bf_lo(unsigned w) { return __uint_as_float(w << 16); }
__device__ __forceinline__ float bf_hi(unsigned w) { return __uint_as_float(w & 0xffff0000u); }
__device__ __forceinline__ f32x4 ldx4(const bf16_t* p) { const u32x2 w = *(const u32x2*)p; return (f32x4){bf_lo(w.x), bf_hi(w.x), bf_lo(w.y), bf_hi(w.y)}; }
__device__ __forceinline__ float wave_sum(float v) {
#pragma unroll
    for (int o = 1; o < 64; o <<= 1) v += __shfl_xor(v, o);
    return v;
}
__device__ __forceinline__ float fsilu(float x) { return x * __builtin_amdgcn_rcpf(1.f + __builtin_amdgcn_exp2f(-1.4426950408889634f * x)); }
__device__ __forceinline__ float fsigmoid(float x) { return __builtin_amdgcn_rcpf(1.f + __builtin_amdgcn_exp2f(-1.4426950408889634f * x)); }

namespace pg8 {
constexpr int BM = 256, BK = 64, HALF = 128, HTB = HALF * BK * 2, STAGE_BYTES = 8 * HTB, NXCD = 8, WGM = 4;
__host__ __device__ __forceinline__ int lds_byte(int r, int c) { const int st = (r >> 4) * 2 + (c >> 5), rr = r & 15, cc = c & 31, ob = rr * 64 + cc * 2; return st * 1024 + (ob ^ (((ob >> 9) & 1) << 5)); }
__host__ __device__ __forceinline__ void stage_rc(int b, int& R, int& C) { const int st = b / 1024, sb = b % 1024, swz = sb ^ (((sb >> 9) & 1) << 5); R = (st >> 1) * 16 + swz / 64; C = (st & 1) * 32 + (swz % 64) / 2; }
__host__ __device__ __forceinline__ int perm32(int rho) { const int n = rho >> 4, i = rho & 15; return 8 * (i >> 2) + 4 * n + (i & 3); }

struct Unit { int pm, pn, bn; };
struct Gemm { const bf16_t* A; const bf16_t* Bt; int K, ldA; };

struct TileSched {
    int nM, nN, nwg, G, c, mode; const LAS unsigned char* tile_e;
    __device__ __forceinline__ void init(int nM_, int nN_, int G_, int c_, int mode_, const LAS unsigned char* te) { nM = nM_; nN = nN_; nwg = nM * nN; G = G_; c = c_; mode = mode_; tile_e = te; }
    __device__ __forceinline__ bool next(int i, Unit& u) const {
        const long L = (long)i * G + c; if (L >= nwg) return false;
        int wgid = (int)L; { const int q = nwg / NXCD, r = nwg % NXCD, xcd = wgid % NXCD, off = wgid / NXCD; wgid = (xcd < r ? xcd * (q + 1) : r * (q + 1) + (xcd - r) * q) + off; }
        const int nig = WGM * nN, gid = wgid / nig, fm = gid * WGM, gsz = (nM - fm) < WGM ? (nM - fm) : WGM;
        const int im = fm + ((wgid % nig) % gsz); u.pn = (wgid % nig) / gsz;
        if (mode == 0) { u.pm = im; u.bn = u.pn; }
        else if (mode == 1) { u.pm = im + 1 + (im >= 32 ? 1 : 0); u.bn = u.pn; }
        else { u.pm = im; u.bn = (int)tile_e[im] * nN + u.pn; }
        return true;
    }
};


struct EpiIn {
    typedef f32x4 AccT;
    static constexpr bool PERM = false;
    bf16_t* U; const float* rope;
    __device__ __forceinline__ void operator()(const f32x4 (&acc)[2][2][4][2], const Unit& u, int wr, int wc, int fr, int fq) const {
        const bool rope_tile = (u.pn >= 4 && u.pn < 13) || u.pn == 16;
        const bool do_rope = rope_tile && (u.pm % 33) != 0;
        const int col0 = u.pn * BM + wc * 32 + 4 * fq;
#pragma unroll
        for (int ai = 0; ai < 2; ++ai)
#pragma unroll
            for (int m = 0; m < 4; ++m) {
                const int row = u.pm * BM + ai * HALF + wr * 64 + m * 16 + fr;
                f32x4 cv = {1.f, 1.f, 1.f, 1.f}, sv = {0.f, 0.f, 0.f, 0.f};
                if (do_rope) { const int t = (row % SEG) - CTXL; const int pos = (wc & 1) ? (t & 63) : (t >> 6);
                    cv = *(const f32x4*)(rope + pos * 16 + 4 * fq); sv = *(const f32x4*)(rope + 2048 + pos * 16 + 4 * fq); }
                bf16_t* rowp = U + (size_t)row * DIN + col0;
#pragma unroll
                for (int bj = 0; bj < 2; ++bj) {
                    const f32x4 v0 = acc[ai][bj][m][0], v1 = acc[ai][bj][m][1];
                    const f32x4 o0 = v0 * cv - v1 * sv, o1 = v1 * cv + v0 * sv;
                    u32x2 w0, w1; w0.x = cvtpk(o0[0], o0[1]); w0.y = cvtpk(o0[2], o0[3]); w1.x = cvtpk(o1[0], o1[1]); w1.y = cvtpk(o1[2], o1[3]);
                    *(u32x2*)(rowp + bj * HALF) = w0; *(u32x2*)(rowp + bj * HALF + 16) = w1; }
            }
    }
};
struct EpiInI8 {
    typedef i32x4 AccT;
    static constexpr bool PERM = false;
    static constexpr bool APERM = true;
    bf16_t* U; const float* rope; const float* sa; const float* sw; unsigned char* vt8;
    __device__ __forceinline__ void operator()(const i32x4 (&acc)[2][2][4][2], const Unit& u, int wr, int wc, int fr, int fq) const {
        const bool rope_tile = (u.pn >= 4 && u.pn < 13) || u.pn == 16;
        const bool do_rope = rope_tile && (u.pm % 33) != 0;
        const bool v_tile = (u.pn >= 13 && u.pn < 16) || u.pn == 17;
        const float qs = (u.pn >= 4 && u.pn < 10) ? 0.18033688011112042f : 1.f;
        const int col0 = u.pn * BM + wc * 32 + 4 * fq;
        f32x4 swv[2][2];
#pragma unroll
        for (int bj = 0; bj < 2; ++bj)
#pragma unroll
            for (int n = 0; n < 2; ++n) swv[bj][n] = *(const f32x4*)(sw + col0 + bj * HALF + n * 16);
        const int rowb = u.pm * BM + wr * 64 + 32 * ((fr >> 2) & 1) + 8 * (fr & 3) + 4 * (fr >> 3);
        if (v_tile) {
            const int b = u.pm / 33; const int key0 = u.pm * BM + wr * 64 - b * SEG;
            const int vcb = (u.pn == 17 ? 768 : (u.pn - 13) * 256) + wc * 32 + 4 * fq;
#pragma unroll
            for (int ai = 0; ai < 2; ++ai) {
                float a[4];
#pragma unroll
                for (int m = 0; m < 4; ++m) a[m] = sa[rowb + ai * HALF + m];
                unsigned char* d = vt8 + ((size_t)b * 1024 + vcb) * SEG + key0 + ai * HALF + 4 * fr;
#pragma unroll
                for (int bj = 0; bj < 2; ++bj)
#pragma unroll
                    for (int n = 0; n < 2; ++n)
#pragma unroll
                        for (int i = 0; i < 4; ++i) { float v[4];
#pragma unroll
                            for (int m = 0; m < 4; ++m) v[m] = __builtin_amdgcn_fmed3f((float)acc[ai][bj][m][n][i] * (a[m] * swv[bj][n][i]), -440.f, 440.f);
                            int w = 0; w = __builtin_amdgcn_cvt_pk_fp8_f32(v[0], v[1], w, false); w = __builtin_amdgcn_cvt_pk_fp8_f32(v[2], v[3], w, true);
                            *(unsigned*)(d + (size_t)(bj * HALF + 16 * n + i) * SEG) = (unsigned)w; }
            }
            return;
        }
        if (rope_tile) {
            const int qc = Q8_OFF + (u.pn == 16 ? QB_CK : (u.pn - 4) * BM) + wc * 32 + 8 * fq;
#pragma unroll
            for (int ai = 0; ai < 2; ++ai)
#pragma unroll
                for (int m = 0; m < 4; ++m) {
                    const int row = rowb + ai * HALF + m; const float a = sa[row] * qs;
                    f32x4 cv = {1.f, 1.f, 1.f, 1.f}, sv = {0.f, 0.f, 0.f, 0.f};
                    if (do_rope) { const int t = (row % SEG) - CTXL; const int pos = (wc & 1) ? (t & 63) : (t >> 6);
                        cv = *(const f32x4*)(rope + pos * 16 + 4 * fq); sv = *(const f32x4*)(rope + 2048 + pos * 16 + 4 * fq); }
                    unsigned char* rowp = (unsigned char*)U + (size_t)row * UROWB + qc;
#pragma unroll
                    for (int bj = 0; bj < 2; ++bj) {
                        const i32x4 i0 = acc[ai][bj][m][0], i1 = acc[ai][bj][m][1]; f32x4 v0, v1;
#pragma unroll
                        for (int i = 0; i < 4; ++i) { v0[i] = (float)i0[i] * (a * swv[bj][0][i]); v1[i] = (float)i1[i] * (a * swv[bj][1][i]); }
                        f32x4 o0 = v0 * cv - v1 * sv, o1 = v1 * cv + v0 * sv;
#pragma unroll
                        for (int i = 0; i < 4; ++i) { o0[i] = __builtin_amdgcn_fmed3f(o0[i], -440.f, 440.f); o1[i] = __builtin_amdgcn_fmed3f(o1[i], -440.f, 440.f); }
                        int w0 = 0, w1 = 0;
                        w0 = __builtin_amdgcn_cvt_pk_fp8_f32(o0[0], o0[1], w0, false); w0 = __builtin_amdgcn_cvt_pk_fp8_f32(o0[2], o0[3], w0, true);
                        w1 = __builtin_amdgcn_cvt_pk_fp8_f32(o1[0], o1[1], w1, false); w1 = __builtin_amdgcn_cvt_pk_fp8_f32(o1[2], o1[3], w1, true);
                        *(u32x2*)(rowp + bj * HALF) = (u32x2){(unsigned)w0, (unsigned)w1};
                    }
                }
            return;
        }
        const int colp = u.pn * BM + wc * 32 + 8 * fq;
#pragma unroll
        for (int ai = 0; ai < 2; ++ai)
#pragma unroll
            for (int m = 0; m < 4; ++m) {
                const int row = rowb + ai * HALF + m; const float a = sa[row];
                bf16_t* rowp = U + (size_t)row * DIN + colp;
#pragma unroll
                for (int bj = 0; bj < 2; ++bj) {
                    const i32x4 i0 = acc[ai][bj][m][0], i1 = acc[ai][bj][m][1]; f32x4 o0, o1;
#pragma unroll
                    for (int i = 0; i < 4; ++i) { o0[i] = (float)i0[i] * (a * swv[bj][0][i]); o1[i] = (float)i1[i] * (a * swv[bj][1][i]); }
                    u32x4 w; w.x = cvtpk(o0[0], o0[1]); w.y = cvtpk(o0[2], o0[3]); w.z = cvtpk(o1[0], o1[1]); w.w = cvtpk(o1[2], o1[3]);
                    *(u32x4*)(rowp + bj * HALF) = w;
                }
            }
    }
};
struct EpiRes {
    typedef f32x4 AccT;
    static constexpr bool PERM = false;
    const float* x; const float* ctx; const float* xl; int from_inputs; float* out; const float* ada; int goff;
    __device__ __forceinline__ void operator()(const f32x4 (&acc)[2][2][4][2], const Unit& u, int wr, int wc, int fr, int fq) const {
        const int b = u.pm / 33, j = u.pm % 33;
        const float* base = from_inputs ? (j == 0 ? ctx + (size_t)b * CTXL * DM : x + ((size_t)b * SEQ + (size_t)(j - 1) * BM) * DM) : xl + (size_t)u.pm * BM * DM;
        float* outp = out + (size_t)u.pm * BM * DM;
        const float* gate = ada + (j == 0 ? 2 : b) * ADA_N + goff;
        const int col0 = u.pn * BM + wc * 32 + 4 * fq;
        f32x4 gv[2][2];
#pragma unroll
        for (int bj = 0; bj < 2; ++bj)
#pragma unroll
            for (int n = 0; n < 2; ++n) gv[bj][n] = *(const f32x4*)(gate + col0 + bj * HALF + n * 16);
#pragma unroll
        for (int ai = 0; ai < 2; ++ai)
#pragma unroll
            for (int mp = 0; mp < 2; ++mp) {
                f32x4 bs[2][2][2];
#pragma unroll
                for (int mm = 0; mm < 2; ++mm) { const size_t off = (size_t)(ai * HALF + wr * 64 + (2 * mp + mm) * 16 + fr) * DM + col0;
#pragma unroll
                    for (int bj = 0; bj < 2; ++bj)
#pragma unroll
                        for (int n = 0; n < 2; ++n) bs[mm][bj][n] = *(const f32x4*)(base + off + bj * HALF + n * 16); }
#pragma unroll
                for (int mm = 0; mm < 2; ++mm) { const size_t off = (size_t)(ai * HALF + wr * 64 + (2 * mp + mm) * 16 + fr) * DM + col0;
#pragma unroll
                    for (int bj = 0; bj < 2; ++bj)
#pragma unroll
                        for (int n = 0; n < 2; ++n) *(f32x4*)(outp + off + bj * HALF + n * 16) = bs[mm][bj][n] + gv[bj][n] * acc[ai][bj][2 * mp + mm][n]; }
            }
    }
};
struct EpiGlu {
    typedef f32x4 AccT;
    static constexpr bool PERM = true;
    bf16_t* O;
    __device__ __forceinline__ void operator()(const f32x4 (&acc)[2][2][4][2], const Unit& u, int wr, int wc, int fr, int fq) const {
        const int col0 = u.pn * HALF + wc * 32 + 8 * fq;
#pragma unroll
        for (int ai = 0; ai < 2; ++ai)
#pragma unroll
            for (int m = 0; m < 4; ++m) { bf16_t* rowp = O + (size_t)(u.pm * BM + ai * HALF + wr * 64 + m * 16 + fr) * DFF + col0;
                const f32x4 g0 = acc[ai][0][m][0], g1 = acc[ai][0][m][1], u0 = acc[ai][1][m][0], u1 = acc[ai][1][m][1];
                u32x4 w; w.x = cvtpk(fsilu(g0[0]) * u0[0], fsilu(g0[1]) * u0[1]); w.y = cvtpk(fsilu(g0[2]) * u0[2], fsilu(g0[3]) * u0[3]);
                w.z = cvtpk(fsilu(g1[0]) * u1[0], fsilu(g1[1]) * u1[1]); w.w = cvtpk(fsilu(g1[2]) * u1[2], fsilu(g1[3]) * u1[3]);
                *(u32x4*)rowp = w; }
    }
};
struct EpiGluI8 {
    typedef i32x4 AccT;
    static constexpr bool PERM = true;
    unsigned char* O; const float* sa; const float* sw;
    __device__ __forceinline__ void operator()(const i32x4 (&acc)[2][2][4][2], const Unit& u, int wr, int wc, int fr, int fq) const {
        const int col0 = u.pn * HALF + wc * 32 + 8 * fq;
        const float* swp = sw + (size_t)u.bn * BM + wc * 32 + 8 * fq;
        const f32x4 sg0 = *(const f32x4*)(swp), sg1 = *(const f32x4*)(swp + 4), su0 = *(const f32x4*)(swp + HALF), su1 = *(const f32x4*)(swp + HALF + 4);
#pragma unroll
        for (int ai = 0; ai < 2; ++ai)
#pragma unroll
            for (int m = 0; m < 4; ++m) { const int row = u.pm * BM + ai * HALF + wr * 64 + m * 16 + fr; unsigned char* rowp = O + (size_t)row * DFF + col0; const float a = sa[row];
                const i32x4 ig0 = acc[ai][0][m][0], ig1 = acc[ai][0][m][1], iu0 = acc[ai][1][m][0], iu1 = acc[ai][1][m][1];
                f32x4 h0, h1;
#pragma unroll
                for (int i = 0; i < 4; ++i) { const float g0 = (float)ig0[i] * (a * sg0[i]), g1 = (float)ig1[i] * (a * sg1[i]), u0 = (float)iu0[i] * (a * su0[i]), u1 = (float)iu1[i] * (a * su1[i]);
                    h0[i] = __builtin_amdgcn_fmed3f(g0 * __builtin_amdgcn_rcpf(1.f + __builtin_amdgcn_exp2f(-g0)) * u0, -440.f, 440.f);
                    h1[i] = __builtin_amdgcn_fmed3f(g1 * __builtin_amdgcn_rcpf(1.f + __builtin_amdgcn_exp2f(-g1)) * u1, -440.f, 440.f); }
                unsigned w0 = 0u, w1 = 0u;
                w0 = __builtin_amdgcn_cvt_pk_fp8_f32(h0[0], h0[1], w0, false); w0 = __builtin_amdgcn_cvt_pk_fp8_f32(h0[2], h0[3], w0, true);
                w1 = __builtin_amdgcn_cvt_pk_fp8_f32(h1[0], h1[1], w1, false); w1 = __builtin_amdgcn_cvt_pk_fp8_f32(h1[2], h1[3], w1, true);
                *(u32x2*)rowp = (u32x2){w0, w1}; }
    }
};
struct EpiResI8 {
    typedef i32x4 AccT;
    static constexpr bool PERM = true;
    bf16_t* xl; const float* ada; int goff; const float* sa; const float* sw; const float* x; const float* ctx; int from_inputs;
    __device__ __forceinline__ void operator()(const i32x4 (&acc)[2][2][4][2], const Unit& u, int wr, int wc, int fr, int fq) const {
        const int b = u.pm / 33, j = u.pm % 33;
        bf16_t* outp = xl + (size_t)u.pm * BM * DM;
        const float* basef = j == 0 ? ctx + (size_t)b * CTXL * DM : x + ((size_t)b * SEQ + (size_t)(j - 1) * BM) * DM;
        const float* gate = ada + (j == 0 ? 2 : b) * ADA_N + goff;
        const int col0 = u.pn * BM + wc * 32 + 8 * fq;
        f32x4 gv[2][2];
#pragma unroll
        for (int bj = 0; bj < 2; ++bj)
#pragma unroll
            for (int n = 0; n < 2; ++n) gv[bj][n] = *(const f32x4*)(gate + col0 + bj * HALF + n * 4) * *(const f32x4*)(sw + col0 + bj * HALF + n * 4);
#pragma unroll
        for (int ai = 0; ai < 2; ++ai)
#pragma unroll
            for (int mp = 0; mp < 2; ++mp) {
                f32x4 bs[2][2][2]; float a[2];
#pragma unroll
                for (int mm = 0; mm < 2; ++mm) { const int r = ai * HALF + wr * 64 + (2 * mp + mm) * 16 + fr; const size_t off = (size_t)r * DM + col0; a[mm] = sa[u.pm * BM + r];
#pragma unroll
                    for (int bj = 0; bj < 2; ++bj) {
                        if (from_inputs) { bs[mm][bj][0] = *(const f32x4*)(basef + off + bj * HALF); bs[mm][bj][1] = *(const f32x4*)(basef + off + bj * HALF + 4); }
                        else { const u32x4 w = *(const u32x4*)(outp + off + bj * HALF); bs[mm][bj][0] = (f32x4){bf_lo(w.x), bf_hi(w.x), bf_lo(w.y), bf_hi(w.y)}; bs[mm][bj][1] = (f32x4){bf_lo(w.z), bf_hi(w.z), bf_lo(w.w), bf_hi(w.w)}; } } }
#pragma unroll
                for (int mm = 0; mm < 2; ++mm) { const size_t off = (size_t)(ai * HALF + wr * 64 + (2 * mp + mm) * 16 + fr) * DM + col0;
#pragma unroll
                    for (int bj = 0; bj < 2; ++bj) { f32x4 rr[2];
#pragma unroll
                        for (int n = 0; n < 2; ++n) { const i32x4 iv = acc[ai][bj][2 * mp + mm][n]; f32x4 fv;
#pragma unroll
                            for (int i = 0; i < 4; ++i) fv[i] = (float)iv[i] * a[mm];
                            rr[n] = bs[mm][bj][n] + gv[bj][n] * fv; }
                        u32x4 w; w.x = cvtpk(rr[0][0], rr[0][1]); w.y = cvtpk(rr[0][2], rr[0][3]); w.z = cvtpk(rr[1][0], rr[1][1]); w.w = cvtpk(rr[1][2], rr[1][3]);
                        *(u32x4*)(outp + off + bj * HALF) = w; } }
            }
    }
};
struct EpiBf16I8 {
    typedef i32x4 AccT;
    static constexpr bool PERM = true;
    bf16_t* O; const float* sa; const float* sw;
    __device__ __forceinline__ void operator()(const i32x4 (&acc)[2][2][4][2], const Unit& u, int wr, int wc, int fr, int fq) const {
        const int col0 = u.pn * BM + wc * 32 + 8 * fq;
        const float* swp = sw + (size_t)u.bn * BM + wc * 32 + 8 * fq;
        f32x4 s0[2], s1[2];
#pragma unroll
        for (int bj = 0; bj < 2; ++bj) { s0[bj] = *(const f32x4*)(swp + bj * HALF); s1[bj] = *(const f32x4*)(swp + bj * HALF + 4); }
#pragma unroll
        for (int ai = 0; ai < 2; ++ai)
#pragma unroll
            for (int m = 0; m < 4; ++m) { const int row = u.pm * BM + ai * HALF + wr * 64 + m * 16 + fr; bf16_t* rowp = O + (size_t)row * DM + col0; const float a = sa[row];
#pragma unroll
                for (int bj = 0; bj < 2; ++bj) { const i32x4 i0 = acc[ai][bj][m][0], i1 = acc[ai][bj][m][1]; f32x4 v0, v1;
#pragma unroll
                    for (int i = 0; i < 4; ++i) { v0[i] = (float)i0[i] * (a * s0[bj][i]); v1[i] = (float)i1[i] * (a * s1[bj][i]); }
                    u32x4 w; w.x = cvtpk(v0[0], v0[1]); w.y = cvtpk(v0[2], v0[3]); w.z = cvtpk(v1[0], v1[1]); w.w = cvtpk(v1[2], v1[3]);
                    *(u32x4*)(rowp + bj * HALF) = w; } }
    }
};
struct EpiResF8 {
    typedef f32x4 AccT;
    static constexpr bool PERM = true;
    bf16_t* xl; const float* ada; int goff; const float* sw;
    __device__ __forceinline__ void operator()(const f32x4 (&acc)[2][2][4][2], const Unit& u, int wr, int wc, int fr, int fq) const {
        const int b = u.pm / 33, j = u.pm % 33;
        bf16_t* outp = xl + (size_t)u.pm * BM * DM;
        const float* gate = ada + (j == 0 ? 2 : b) * ADA_N + goff;
        const int col0 = u.pn * BM + wc * 32 + 8 * fq;
        f32x4 gv[2][2];
#pragma unroll
        for (int bj = 0; bj < 2; ++bj)
#pragma unroll
            for (int n = 0; n < 2; ++n) gv[bj][n] = *(const f32x4*)(gate + col0 + bj * HALF + n * 4) * *(const f32x4*)(sw + col0 + bj * HALF + n * 4) * 0.25f;
#pragma unroll
        for (int ai = 0; ai < 2; ++ai)
#pragma unroll
            for (int mp = 0; mp < 2; ++mp) {
                u32x4 bs[2][2];
#pragma unroll
                for (int mm = 0; mm < 2; ++mm) { const size_t off = (size_t)(ai * HALF + wr * 64 + (2 * mp + mm) * 16 + fr) * DM + col0;
#pragma unroll
                    for (int bj = 0; bj < 2; ++bj) bs[mm][bj] = *(const u32x4*)(outp + off + bj * HALF); }
#pragma unroll
                for (int mm = 0; mm < 2; ++mm) { const size_t off = (size_t)(ai * HALF + wr * 64 + (2 * mp + mm) * 16 + fr) * DM + col0;
#pragma unroll
                    for (int bj = 0; bj < 2; ++bj) { const u32x4 w0 = bs[mm][bj];
                        const f32x4 b0 = {bf_lo(w0.x), bf_hi(w0.x), bf_lo(w0.y), bf_hi(w0.y)}, b1 = {bf_lo(w0.z), bf_hi(w0.z), bf_lo(w0.w), bf_hi(w0.w)};
                        const f32x4 r0 = b0 + gv[bj][0] * acc[ai][bj][2 * mp + mm][0], r1 = b1 + gv[bj][1] * acc[ai][bj][2 * mp + mm][1];
                        u32x4 w; w.x = cvtpk(r0[0], r0[1]); w.y = cvtpk(r0[2], r0[3]); w.z = cvtpk(r1[0], r1[1]); w.w = cvtpk(r1[2], r1[3]);
                        *(u32x4*)(outp + off + bj * HALF) = w; } }
            }
    }
};
struct EpiBf16F8 {
    typedef f32x4 AccT;
    static constexpr bool PERM = true;
    bf16_t* O; const float* sw;
    __device__ __forceinline__ void operator()(const f32x4 (&acc)[2][2][4][2], const Unit& u, int wr, int wc, int fr, int fq) const {
        const int col0 = u.pn * BM + wc * 32 + 8 * fq;
        const float* swp = sw + (size_t)u.bn * BM + wc * 32 + 8 * fq;
        f32x4 s0[2], s1[2];
#pragma unroll
        for (int bj = 0; bj < 2; ++bj) { s0[bj] = *(const f32x4*)(swp + bj * HALF) * 0.25f; s1[bj] = *(const f32x4*)(swp + bj * HALF + 4) * 0.25f; }
#pragma unroll
        for (int ai = 0; ai < 2; ++ai)
#pragma unroll
            for (int m = 0; m < 4; ++m) { bf16_t* rowp = O + (size_t)(u.pm * BM + ai * HALF + wr * 64 + m * 16 + fr) * DM + col0;
#pragma unroll
                for (int bj = 0; bj < 2; ++bj) { const f32x4 v0 = acc[ai][bj][m][0] * s0[bj], v1 = acc[ai][bj][m][1] * s1[bj];
                    u32x4 w; w.x = cvtpk(v0[0], v0[1]); w.y = cvtpk(v0[2], v0[3]); w.z = cvtpk(v1[0], v1[1]); w.w = cvtpk(v1[2], v1[3]);
                    *(u32x4*)(rowp + bj * HALF) = w; } }
    }
};
struct EpiBf16 {
    typedef f32x4 AccT;
    static constexpr bool PERM = true;
    bf16_t* O;
    __device__ __forceinline__ void operator()(const f32x4 (&acc)[2][2][4][2], const Unit& u, int wr, int wc, int fr, int fq) const {
        const int col0 = u.pn * BM + wc * 32 + 8 * fq;
#pragma unroll
        for (int ai = 0; ai < 2; ++ai)
#pragma unroll
            for (int m = 0; m < 4; ++m) { bf16_t* rowp = O + (size_t)(u.pm * BM + ai * HALF + wr * 64 + m * 16 + fr) * DM + col0;
#pragma unroll
                for (int bj = 0; bj < 2; ++bj) { const f32x4 v0 = acc[ai][bj][m][0], v1 = acc[ai][bj][m][1];
                    u32x4 w; w.x = cvtpk(v0[0], v0[1]); w.y = cvtpk(v0[2], v0[3]); w.z = cvtpk(v1[0], v1[1]); w.w = cvtpk(v1[2], v1[3]);
                    *(u32x4*)(rowp + bj * HALF) = w; } }
    }
};

template <class T> struct EpiAPerm { static constexpr bool v = false; };
template <> struct EpiAPerm<EpiInI8> { static constexpr bool v = true; };
template <class T> struct EpiCode { static constexpr int v = 0; };
template <> struct EpiCode<EpiInI8> { static constexpr int v = 1; };
template <> struct EpiCode<EpiGluI8> { static constexpr int v = 2; };
template <> struct EpiCode<EpiBf16F8> { static constexpr int v = 3; };
template <class Epi, bool ALIGN_EPI, int MODE = 0>
__device__ __forceinline__ void gemm_phase(LAS unsigned char* lds, const Gemm g, const TileSched& S, const Epi& E) {
    int tid = threadIdx.x; asm volatile("" : "+v"(tid));
    const int wid = __builtin_amdgcn_readfirstlane(tid >> 6), lane = tid & 63, wr = wid >> 2, wc = wid & 3, fr = lane & 15, fq = lane >> 4;
    const int K = g.K, nt = K / BK;
    unsigned voffA[2], voffB[2];
#pragma unroll
    for (int i = 0; i < 2; ++i) { int R, C; stage_rc((wid * 2 + i) * 1024 + lane * 16, R, C); const int Rb = Epi::PERM ? ((R & ~31) + perm32(R & 31)) : R;
        const int Ra = EpiAPerm<Epi>::v ? ((R & ~63) + 32 * ((R >> 2) & 1) + 8 * (R & 3) + 4 * ((R >> 3) & 1) + ((R >> 4) & 3)) : R;
        voffA[i] = (unsigned)(Ra * g.ldA + C) * 2u + (i == 0 ? 1024u : 0u); voffB[i] = (unsigned)(Rb * K + C) * 2u + (i == 0 ? 1024u : 0u); }
    const size_t kstep = (size_t)(BK * 2);
    const size_t hstep = (size_t)HALF * K * 2, hstepA = (size_t)HALF * g.ldA * 2;
    const size_t tstep = 2 * hstep, tstepA = 2 * hstepA;
    const unsigned ldsw = (unsigned)wid * 2048u + 1024u, ldsb = (unsigned)(uintptr_t)lds;
    const int aoff = lds_byte(wr * 64 + fr, fq * 8), boff = lds_byte(wc * 32 + fr, fq * 8);
#define PG8_SA(b, h) (((b) * 2 + (h)) * HTB)
#define PG8_SB(b, h) ((4 + (b) * 2 + (h)) * HTB)
#define PG8_STAGE(bufoff, gbase, voff) do {   \
        asm volatile("s_mov_b32 m0, %3\n\ts_nop 0\n\tglobal_load_lds_dwordx4 %0, %2 offset:-1024\n\tglobal_load_lds_dwordx4 %1, %2" :: "v"((voff)[0]), "v"((voff)[1]), "s"((const char*)(gbase)), "s"(ldsb + (unsigned)(bufoff) + ldsw) : "memory", "m0"); } while (0)
#define PG8_LDA(dst, b, h) do { _Pragma("unroll") for (int m = 0; m < 4; ++m) { const i32x4 lo_ = *(const LAS i32x4*)(lds + PG8_SA(b, h) + aoff + m * 2048), hi_ = *(const LAS i32x4*)(lds + PG8_SA(b, h) + aoff + m * 2048 + 1024); \
        dst[m] = __builtin_shufflevector(lo_, hi_, 0, 1, 2, 3, 4, 5, 6, 7); } } while (0)
#define PG8_LDB(dst, b, h) do { _Pragma("unroll") for (int n = 0; n < 2; ++n) { const i32x4 lo_ = *(const LAS i32x4*)(lds + PG8_SB(b, h) + boff + n * 2048), hi_ = *(const LAS i32x4*)(lds + PG8_SB(b, h) + boff + n * 2048 + 1024); \
        dst[n] = __builtin_shufflevector(lo_, hi_, 0, 1, 2, 3, 4, 5, 6, 7); } } while (0)
#define PG8_MMA(ai, bj, At, Bt) do { __builtin_amdgcn_s_setprio(1); _Pragma("unroll") for (int m = 0; m < 4; ++m) _Pragma("unroll") for (int n = 0; n < 2; ++n) { \
        if constexpr (MODE == 2) {   \
            acc[ai][bj][m][n] = __builtin_amdgcn_mfma_scale_f32_16x16x128_f8f6f4(Bt[n], At[m], acc[ai][bj][m][n], 0, 0, 0, 0, 0, 0); \
        } else if constexpr (MODE == 1) { \
            acc[ai][bj][m][n] = __builtin_amdgcn_mfma_i32_16x16x64_i8(Bt[n].lo, At[m].lo, acc[ai][bj][m][n], 0, 0, 0); acc[ai][bj][m][n] = __builtin_amdgcn_mfma_i32_16x16x64_i8(Bt[n].hi, At[m].hi, acc[ai][bj][m][n], 0, 0, 0); \
        } else { \
            acc[ai][bj][m][n] = __builtin_amdgcn_mfma_f32_16x16x32_bf16(__builtin_bit_cast(bf16x8, Bt[n].lo), __builtin_bit_cast(bf16x8, At[m].lo), acc[ai][bj][m][n], 0, 0, 0); \
            acc[ai][bj][m][n] = __builtin_amdgcn_mfma_f32_16x16x32_bf16(__builtin_bit_cast(bf16x8, Bt[n].hi), __builtin_bit_cast(bf16x8, At[m].hi), acc[ai][bj][m][n], 0, 0, 0); } } __builtin_amdgcn_s_setprio(0); } while (0)
#define PG8_WAIT_V(n) asm volatile("s_waitcnt vmcnt(" #n ")" ::: "memory")
#define PG8_WAIT_L(n) asm volatile("s_waitcnt lgkmcnt(" #n ")" ::: "memory")
#define PG8_BAR __builtin_amdgcn_s_barrier()
#define PG8_SCHED __builtin_amdgcn_sched_barrier(0)
    Unit cur, nxt; int ui = 0;
    if (!S.next(0, cur)) return;
    typedef typename Epi::AccT AccT;
    AccT acc[2][2][4][2];
#pragma unroll
    for (int a = 0; a < 2; ++a)
#pragma unroll
        for (int b = 0; b < 2; ++b)
#pragma unroll
            for (int m = 0; m < 4; ++m)
#pragma unroll
                for (int n = 0; n < 2; ++n) acc[a][b][m][n] = (AccT){0, 0, 0, 0};
    i32x8 At[4], B0[2], B1[2];
    const char* cA = (const char*)g.A + (size_t)cur.pm * tstepA; const char* cB = (const char*)g.Bt + (size_t)cur.bn * tstep;
    PG8_STAGE(PG8_SB(0, 0), cB, voffB); PG8_STAGE(PG8_SB(0, 1), cB + hstep, voffB); PG8_STAGE(PG8_SA(0, 0), cA, voffA); PG8_STAGE(PG8_SA(0, 1), cA + hstepA, voffA);
    if (wr == 1) PG8_BAR;
    PG8_WAIT_V(2); PG8_BAR;
    PG8_STAGE(PG8_SB(1, 0), cB + kstep, voffB); PG8_STAGE(PG8_SA(1, 0), cA + kstep, voffA); PG8_STAGE(PG8_SB(1, 1), cB + hstep + kstep, voffB);
    PG8_WAIT_V(6); PG8_BAR;
    for (;;) {
        const bool has_next = S.next(ui + 1, nxt);
        const char* nA = has_next ? (const char*)g.A + (size_t)nxt.pm * tstepA : cA; const char* nB = has_next ? (const char*)g.Bt + (size_t)nxt.bn * tstep : cB;
        for (int t = 0; t < nt; t += 2) {
            const bool last = (t == nt - 2);
            const char* a1 = cA + (size_t)(t + 1) * kstep;
            const char* a2 = last ? nA : cA + (size_t)(t + 2) * kstep; const char* b2 = last ? nB : cB + (size_t)(t + 2) * kstep;
            const char* a3 = a2 + kstep; const char* b3 = b2 + kstep;
            int relax = __builtin_amdgcn_readfirstlane((t == 0) & (ui > 0)); asm volatile("" : "+s"(relax));
            PG8_LDB(B0, 0, 0); PG8_LDB(B1, 0, 1); PG8_SCHED; PG8_LDA(At, 0, 0); PG8_STAGE(PG8_SA(1, 1), a1 + hstepA, voffA);
            if (relax) { PG8_WAIT_V(63); } else { PG8_WAIT_V(8); } PG8_WAIT_L(0); PG8_BAR; PG8_MMA(0, 0, At, B0); PG8_MMA(0, 1, At, B1); PG8_BAR; PG8_SCHED;
            PG8_LDA(At, 0, 1); PG8_STAGE(PG8_SB(0, 0), b2, voffB); PG8_STAGE(PG8_SB(0, 1), b2 + hstep, voffB); PG8_STAGE(PG8_SA(0, 0), a2, voffA);
            if (relax) { PG8_WAIT_V(63); } else { PG8_WAIT_V(8); } PG8_WAIT_L(0); PG8_BAR; PG8_MMA(1, 0, At, B0); PG8_MMA(1, 1, At, B1); PG8_BAR; PG8_SCHED;
            PG8_LDB(B0, 1, 0); PG8_LDB(B1, 1, 1); PG8_SCHED; PG8_LDA(At, 1, 0); PG8_STAGE(PG8_SA(0, 1), a2 + hstepA, voffA);
            PG8_WAIT_V(8); PG8_WAIT_L(0); PG8_BAR; PG8_MMA(0, 0, At, B0); PG8_MMA(0, 1, At, B1); PG8_BAR; PG8_SCHED;
            PG8_LDA(At, 1, 1); PG8_STAGE(PG8_SB(1, 0), b3, voffB); PG8_STAGE(PG8_SB(1, 1), b3 + hstep, voffB); PG8_STAGE(PG8_SA(1, 0), a3, voffA);
            PG8_WAIT_V(8); PG8_WAIT_L(0); PG8_BAR; PG8_MMA(1, 0, At, B0); PG8_MMA(1, 1, At, B1); PG8_BAR; PG8_SCHED;
        }
        if constexpr (ALIGN_EPI) { if (wr == 0) PG8_BAR; }
        { int fr_ = fr, fq_ = fq; asm volatile("" : "+v"(fr_), "+v"(fq_));
          E(acc, cur, wr, wc, fr_, fq_);
          if constexpr (PROBE_EPI2 != 0 && EpiCode<Epi>::v == PROBE_EPI2) { asm volatile("" : "+v"(fr_), "+v"(fq_) :: "memory"); E(acc, cur, wr, wc, fr_, fq_); } }
        if (!has_next) break;
#pragma unroll
        for (int a = 0; a < 2; ++a)
#pragma unroll
            for (int b = 0; b < 2; ++b)
#pragma unroll
                for (int m = 0; m < 4; ++m)
#pragma unroll
                    for (int n = 0; n < 2; ++n) acc[a][b][m][n] = (AccT){0, 0, 0, 0};
        cur = nxt; cA = nA; cB = nB; ++ui;
        if constexpr (ALIGN_EPI) { if (wr == 1) PG8_BAR; }
    }
    PG8_WAIT_V(0);
    if constexpr (!ALIGN_EPI) { if (wr == 0) PG8_BAR; }
    PG8_BAR;
#undef PG8_SA
#undef PG8_SB
#undef PG8_STAGE
#undef PG8_LDA
#undef PG8_LDB
#undef PG8_MMA
#undef PG8_WAIT_V
#undef PG8_WAIT_L
#undef PG8_BAR
#undef PG8_SCHED
}
}

namespace att {
constexpr float SCALE = 0.125f;
constexpr float THR = 8.f;
constexpr int V_BYTES = 8192, K_BYTES = 4096;
constexpr int LDS_V = 0, LDS_K = 3 * V_BYTES, LDS_WS = LDS_K + 3 * K_BYTES, LDS_TOTAL = LDS_WS + NWAVES * 64 * 4;
#define SBAR() __builtin_amdgcn_sched_barrier(0)
__device__ __forceinline__ int crow(int r, int hi) { return (r & 3) + 8 * (r >> 2) + 4 * hi; }
constexpr float THR2 = 8.f;
template <bool FIRST>
__device__ __forceinline__ void partialSM(f32x16& p0, f32x16& p1, float& mref, f32x16& negm, float& alpha) {
    float pa_ = fmaxf(fmaxf(p0[0], p0[1]), p1[0]), pb_ = fmaxf(fmaxf(p0[2], p0[3]), p1[1]); pa_ = fmaxf(fmaxf(pa_, p1[2]), p1[3]);
#pragma unroll
    for (int r = 4; r < 16; r += 4) { pa_ = fmaxf(fmaxf(pa_, p0[r]), p0[r + 1]); pb_ = fmaxf(fmaxf(pb_, p0[r + 2]), p0[r + 3]); pa_ = fmaxf(fmaxf(pa_, p1[r]), p1[r + 1]); pb_ = fmaxf(fmaxf(pb_, p1[r + 2]), p1[r + 3]); }
    float pmax = fmaxf(pa_, pb_);
    { auto rr = __builtin_amdgcn_permlane32_swap(__float_as_uint(pmax), __float_as_uint(pmax), false, false);
      pmax = fmaxf(__uint_as_float(rr[0]), __uint_as_float(rr[1])); }
    alpha = 1.f;
    if (FIRST || __builtin_expect(__any(pmax > THR2), 0)) {
        const float dl = FIRST ? pmax : fmaxf(pmax, 0.f);
        mref += dl; alpha = __builtin_amdgcn_exp2f(-dl);
#pragma unroll
        for (int r = 0; r < 16; ++r) { p0[r] -= dl; p1[r] -= dl; }
        const float nm = -mref;
#pragma unroll
        for (int r = 0; r < 16; ++r) negm[r] = nm;
        asm volatile("" : "+v"(negm));
    }
#pragma unroll
    for (int r = 0; r < 16; ++r) p0[r] = __builtin_amdgcn_exp2f(p0[r]);
}
__device__ __forceinline__ void finishSM(f32x16& p0, f32x16& p1, i32x8& P8) {
#pragma unroll
    for (int r = 0; r < 16; ++r) p1[r] = __builtin_amdgcn_exp2f(p1[r]);
#pragma unroll
    for (int w = 0; w < 4; ++w) { int x, y; asm volatile("" : "=v"(x), "=v"(y));
        x = __builtin_amdgcn_cvt_pk_fp8_f32(p0[4 * w], p0[4 * w + 1], x, false); x = __builtin_amdgcn_cvt_pk_fp8_f32(p0[4 * w + 2], p0[4 * w + 3], x, true); P8[w] = x;
        y = __builtin_amdgcn_cvt_pk_fp8_f32(p1[4 * w], p1[4 * w + 1], y, false); y = __builtin_amdgcn_cvt_pk_fp8_f32(p1[4 * w + 2], p1[4 * w + 3], y, true); P8[4 + w] = y; }
}
__device__ __forceinline__ void kload(i32x8 (&kf)[2], const LAS unsigned char* Ks, int vfa, int vfb) {
#pragma unroll
    for (int d0 = 0; d0 < 2; ++d0) { const i32x4 lo_ = *(const LAS i32x4*)(Ks + d0 * 2048 + vfa), hi_ = *(const LAS i32x4*)(Ks + d0 * 2048 + vfb); kf[d0] = __builtin_shufflevector(lo_, hi_, 0, 1, 2, 3, 4, 5, 6, 7); }
}
__device__ __forceinline__ void qk_mma(f32x16& p0, f32x16& p1, const i32x8 (&kf)[2], const i32x8& q8, const f32x16& negm) {
    p0 = __builtin_amdgcn_mfma_scale_f32_32x32x64_f8f6f4(kf[0], q8, negm, 0, 0, 0, 0, 0, 0);
    p1 = __builtin_amdgcn_mfma_scale_f32_32x32x64_f8f6f4(kf[1], q8, negm, 0, 0, 0, 0, 0, 0);
}
template <int DV> __device__ __forceinline__ void pv_all(f32x16* o, f32x16& lacc, const LAS unsigned char* Vs, int vfa, int vfb, const i32x8& P8, const i32x8& ones) {
    i32x8 V8[DV / 32];
#pragma unroll
    for (int d0 = 0; d0 < DV / 32; ++d0) { const i32x4 lo_ = *(const LAS i32x4*)(Vs + d0 * 2048 + vfa), hi_ = *(const LAS i32x4*)(Vs + d0 * 2048 + vfb); V8[d0] = __builtin_shufflevector(lo_, hi_, 0, 1, 2, 3, 4, 5, 6, 7); }
    lacc = __builtin_amdgcn_mfma_scale_f32_32x32x64_f8f6f4(P8, ones, lacc, 0, 0, 0, 0, 0, 0);
#pragma unroll
    for (int d0 = 0; d0 < DV / 32; ++d0) o[d0] = __builtin_amdgcn_mfma_scale_f32_32x32x64_f8f6f4(P8, V8[d0], o[d0], 0, 0, 0, 0, 0, 0);
}
__device__ __forceinline__ void wmask(f32x16& p0, f32x16& p1, int dt, int hi) {
    const int lo = dt - 128, hb = dt + 128;
#pragma unroll
    for (int r = 0; r < 16; ++r) { const int k0 = crow(r, hi), k1 = k0 + 32;
        if (k0 < lo || k0 > hb) p0[r] = -1e30f; if (k1 < lo || k1 > hb) p1[r] = -1e30f; }
}

__device__ __forceinline__ void glds16(const void* gsrc, unsigned lds_dst) {
    asm volatile("s_mov_b32 m0, %1\n\ts_nop 0\n\tglobal_load_lds_dwordx4 %0, off" :: "v"(gsrc), "s"(lds_dst) : "memory", "m0"); }
#define WAIT_BAR(N) asm volatile("s_waitcnt vmcnt(" #N ") lgkmcnt(0)\n\ts_barrier" ::: "memory")
template <int DV, bool SWA>
__device__ __forceinline__ void attn_unit(const unsigned char* __restrict__ Qb, const unsigned char* __restrict__ Kseg, const unsigned char* __restrict__ Vt, int NT, int loc0,
                                          bool masked, int dq0, float sinkv, bf16_t* Ob, int ldo, LAS unsigned char* lds) {
    int tid = threadIdx.x; asm volatile("" : "+v"(tid));
    const int lane = tid & 63, r32 = lane & 31, hi = lane >> 5; const int wid = __builtin_amdgcn_readfirstlane(tid >> 6);
    LAS unsigned char* V_lds = lds + LDS_V; LAS unsigned char* K_lds = lds + LDS_K;
    LAS float* wsf = (LAS float*)(lds + LDS_WS) + wid * 64; LAS float* al_l = wsf;
    float mref = SWA ? sinkv * 1.4426950408889634f : 0.f;
    f32x16 negm, lacc;
#pragma unroll
    for (int r = 0; r < 16; ++r) { negm[r] = -mref; lacc[r] = SWA ? 1.f : 0.f; }
    asm volatile("" : "+v"(negm));
    f32x16 o[DV / 32];
#pragma unroll
    for (int d = 0; d < DV / 32; ++d) o[d] = f32x16{};
    asm volatile("s_waitcnt vmcnt(0)" ::: "memory");
    i32x8 q8;
    { const unsigned char* Qw = Qb + (size_t)(wid * 32 + r32) * UROWB + hi * 32;
      const i32x4 lo_ = *(const i32x4*)Qw, hi_ = *(const i32x4*)(Qw + 16); q8 = __builtin_shufflevector(lo_, hi_, 0, 1, 2, 3, 4, 5, 6, 7); }
    const int kw = wid & 3, kg = kw * 64 + lane, kcol = kg >> 2, kch = (kg & 3) ^ ((kcol >> 2) & 3);
    const unsigned char* ksrc = Kseg + (size_t)kcol * UROWB + kch * 16;
    const int vw = DV == 128 ? wid : (wid & 3);
    const unsigned kdst = (unsigned)(uintptr_t)K_lds + kw * 1024, vdst = (unsigned)(uintptr_t)V_lds + vw * 1024;
    const int vg = vw * 64 + lane, vcol = vg >> 2, vch = (vg & 3) ^ ((vcol >> 2) & 3);
    const unsigned char* vsrc = Vt + (size_t)vcol * SEG + vch * 16;
    const int vx = (r32 >> 2) & 3, vfa = r32 * 64 + (((2 * hi) ^ vx) << 4), vfb = r32 * 64 + (((2 * hi + 1) ^ vx) << 4);
#define TROW(t) ((t) < 4 ? (t) * 64 : loc0 + ((t) - 4) * 64)
#define DMA_K(t, slot) glds16(ksrc + (size_t)TROW(t) * UROWB, (unsigned)__builtin_amdgcn_readfirstlane(kdst + (slot) * K_BYTES))
#define DMA_V(t, slot) glds16(vsrc + TROW(t), (unsigned)__builtin_amdgcn_readfirstlane(vdst + (slot) * V_BYTES))
#define RESC(a) do { if (__any((a) < 1.f)) { if (hi == 0) al_l[r32] = (a); asm volatile("s_waitcnt lgkmcnt(0)" ::: "memory"); \
        _Pragma("unroll") for (int r = 0; r < 16; ++r) { const float f_ = al_l[crow(r, hi)]; lacc[r] *= f_; _Pragma("unroll") for (int d = 0; d < DV / 32; ++d) o[d][r] *= f_; } } } while (0)
#define MASK(P0, P1, t) do { if (SWA && masked && (t) >= 4) wmask(P0, P1, dqw - ((t) - 4) * 64, hi); } while (0)
#define ROT() do { const int t_ = sp; sp = sc; sc = sn; sn = t_; } while (0)
    const int dqw = dq0 + wid * 32 + r32;
    f32x16 pA0, pA1, pB0, pB1; float alA, alB; i32x8 P8; i32x8 kf[2];
    i32x8 ones = {0x38383838, 0x38383838, 0x38383838, 0x38383838, 0x38383838, 0x38383838, 0x38383838, 0x38383838};
    asm volatile("" : "+v"(ones));
    int sp = 2, sc = 0, sn = 1;
    if (wid >= 4) __builtin_amdgcn_s_setprio(1);
    DMA_K(0, 0); DMA_V(0, 0); DMA_K(1, 1);
    WAIT_BAR(2);
    DMA_K(2, sp); DMA_V(1, sn);
    kload(kf, K_lds + sc * K_BYTES, vfa, vfb); qk_mma(pA0, pA1, kf, q8, negm); MASK(pA0, pA1, 0); partialSM<!SWA>(pA0, pA1, mref, negm, alA);
    if constexpr (SWA) RESC(alA);
    ROT();
    for (int j = 1; j < NT - 1; j += 2) {
        WAIT_BAR(2);
        SBAR(); kload(kf, K_lds + sc * K_BYTES, vfa, vfb); SBAR();
        DMA_K(j + 2, sp); DMA_V(j + 1, sn);
        SBAR(); qk_mma(pB0, pB1, kf, q8, negm);
        finishSM(pA0, pA1, P8); SBAR();
        pv_all<DV>(o, lacc, V_lds + sp * V_BYTES, vfa, vfb, P8, ones); MASK(pB0, pB1, j); partialSM<false>(pB0, pB1, mref, negm, alB);
        RESC(alB); ROT();
        WAIT_BAR(2);
        SBAR(); kload(kf, K_lds + sc * K_BYTES, vfa, vfb); SBAR();
        if (j + 3 < NT) DMA_K(j + 3, sp);
        DMA_V(j + 2, sn);
        SBAR(); qk_mma(pA0, pA1, kf, q8, negm);
        finishSM(pB0, pB1, P8); SBAR();
        pv_all<DV>(o, lacc, V_lds + sp * V_BYTES, vfa, vfb, P8, ones); MASK(pA0, pA1, j + 1); partialSM<false>(pA0, pA1, mref, negm, alA);
        RESC(alA); ROT();
    }
    WAIT_BAR(1);
    SBAR(); kload(kf, K_lds + sc * K_BYTES, vfa, vfb); qk_mma(pB0, pB1, kf, q8, negm);
    finishSM(pA0, pA1, P8); SBAR();
    pv_all<DV>(o, lacc, V_lds + sp * V_BYTES, vfa, vfb, P8, ones); MASK(pB0, pB1, NT - 1); partialSM<false>(pB0, pB1, mref, negm, alB);
    RESC(alB); ROT();
    WAIT_BAR(0);
    finishSM(pB0, pB1, P8); SBAR();
    pv_all<DV>(o, lacc, V_lds + sp * V_BYTES, vfa, vfb, P8, ones);
    float rli[16];
#pragma unroll
    for (int r = 0; r < 16; ++r) rli[r] = __builtin_amdgcn_rcpf(lacc[r]);
    {
        bf16_t* Ow = Ob + (size_t)(wid * 32) * ldo;
#pragma unroll
        for (int r = 0; r < 16; ++r) { const int orow = crow(r, hi);
#pragma unroll
            for (int d0 = 0; d0 < DV / 32; ++d0) Ow[(size_t)orow * ldo + d0 * 32 + r32] = (bf16_t)(cvtpk(o[d0][r] * rli[r], 0.f) & 0xffffu); }
    }
    __builtin_amdgcn_s_setprio(0);
    __syncthreads();
#undef TROW
#undef DMA_K
#undef DMA_V
#undef RESC
#undef MASK
#undef ROT
}
#undef WAIT_BAR
#undef SBAR
}

#define XB_TMO      128
#define XB_XCNT(j)  (256  + 64 * (j))
#define XB_XSUB(j)  (1280 + 64 * (j))
#define XB_XGEN(j)  (2304 + 64 * (j))
#define XB_TOP      3328
#define XB_TOPGEN   3392
#define XCD_BAR_WORDS 3456
#define XB_SPIN_CAP (1u << 18)
__device__ __forceinline__ unsigned xb_ld(unsigned* p)              { return __hip_atomic_load(p, __ATOMIC_RELAXED, __HIP_MEMORY_SCOPE_AGENT); }
__device__ __forceinline__ unsigned xb_add(unsigned* p, unsigned v) { return __hip_atomic_fetch_add(p, v, __ATOMIC_RELAXED, __HIP_MEMORY_SCOPE_AGENT); }
__device__ __forceinline__ unsigned xb_xcc_id() { return (unsigned)__builtin_amdgcn_s_getreg((3 << 11) | 20) & 0xFu; }
#define XB_SPIN(cond, bar) do { unsigned _sp = 0; while (cond) { __builtin_amdgcn_s_sleep(1); \
    if ((++_sp & 255u) == 0u) { if (xb_ld(&(bar)[XB_TMO])) break; if (_sp > XB_SPIN_CAP) { atomicAdd(&(bar)[XB_TMO], 1u); break; } } } } while (0)
struct XcdBarrier { unsigned* bar; unsigned x; volatile LAS unsigned* st; };
__device__ __forceinline__ XcdBarrier xcd_barrier_post(unsigned* bar, volatile LAS unsigned* st) {
    XcdBarrier b; b.bar = bar; b.x = xb_xcc_id(); b.st = st;
    if (threadIdx.x == 0) (void)xb_add(&bar[XB_XCNT(b.x)], 1u);
    return b;
}
__device__ __forceinline__ void xcd_barrier_complete(unsigned* bar, unsigned x, unsigned& nloc, unsigned& nx) {
    const unsigned G = gridDim.x * gridDim.y * gridDim.z;
    unsigned sum, cnt, mine, sp = 0u;
    for (;;) {
        sum = 0u; cnt = 0u; mine = 0u;
#pragma unroll
        for (unsigned j = 0; j < 16; ++j) { const unsigned c = xb_ld(&bar[XB_XCNT(j)]); sum += c; cnt += (c > 0u) ? 1u : 0u; mine = (j == x) ? c : mine; }
        if (sum == G) break;
        __builtin_amdgcn_s_sleep(1);
        if ((++sp & 255u) == 0u) { if (xb_ld(&bar[XB_TMO])) break; if (sp > XB_SPIN_CAP) { atomicAdd(&bar[XB_TMO], 1u); break; } }
    }
    nloc = mine > 0u ? mine : 1u; nx = cnt > 0u ? cnt : 1u;
}
__device__ __forceinline__ void xcd_barrier(const XcdBarrier& b) {
    asm volatile("s_waitcnt vmcnt(0)" ::: "memory");
    __syncthreads();
    if (threadIdx.x == 0) {
        unsigned* bar = b.bar;
        __builtin_amdgcn_s_waitcnt(0);
        unsigned nloc = b.st[0], nx = b.st[1];
        if (nloc == 0u) { xcd_barrier_complete(bar, b.x, nloc, nx); b.st[0] = nloc; b.st[1] = nx; }
        const unsigned old = xb_add(&bar[XB_XSUB(b.x)], 1u);
        const unsigned gen = old / nloc;
        if (old + 1u == (gen + 1u) * nloc) {
            __builtin_amdgcn_fence(__ATOMIC_RELEASE, "agent");
            asm volatile("s_waitcnt vmcnt(0)" ::: "memory");
            const unsigned og = xb_add(&bar[XB_TOP], 1u);
            const unsigned tg = og / nx;
            if (og + 1u == (tg + 1u) * nx) xb_add(&bar[XB_TOPGEN], 1u);
            else XB_SPIN(xb_ld(&bar[XB_TOPGEN]) == tg, bar);
            __builtin_amdgcn_fence(__ATOMIC_ACQUIRE, "agent");
            xb_add(&bar[XB_XGEN(b.x)], 1u);
            asm volatile("s_waitcnt vmcnt(0)" ::: "memory");
        } else {
            XB_SPIN(xb_ld(&bar[XB_XGEN(b.x)]) == gen, bar);
            __builtin_amdgcn_fence(__ATOMIC_ACQUIRE, "agent");
            asm volatile("s_waitcnt vmcnt(0)" ::: "memory");
        }
    }
    __syncthreads();
}

struct Args { const float* in[28]; float* out; unsigned char* ws; int ph_lo, ph_hi; };
enum { I_X = 0, I_C, I_CTX, I_CCTX, I_WADA, I_BADA, I_GN1, I_GN2, I_WIN, I_WDW, I_BDW, I_LNG, I_LNB, I_LQ1, I_LK1, I_LQ2, I_LK2, I_GSUB, I_SINK, I_WOUT,
       I_FFG, I_FFU, I_FFD, I_WR, I_EXG, I_EXU, I_EXD, I_GFIN };

__device__ __forceinline__ void transpose_item(const float* __restrict__ W, int K, int N, bf16_t* __restrict__ WT, int k0, int n0, int drow0, LAS float* scr, int lane) {
    const int r = lane >> 4, c4 = (lane & 15) * 4;
    f32x4 v[16];
#pragma unroll
    for (int i = 0; i < 16; ++i) v[i] = __builtin_nontemporal_load((const f32x4*)(W + (size_t)(k0 + 4 * i + r) * N + n0 + c4));
#pragma unroll
    for (int i = 0; i < 16; ++i) { LAS float* s = scr + (4 * i + r) * 65 + c4; s[0] = v[i][0]; s[1] = v[i][1]; s[2] = v[i][2]; s[3] = v[i][3]; }
    asm volatile("s_waitcnt lgkmcnt(0)" ::: "memory");
    const int c = lane & 7, nn = lane >> 3;
#pragma unroll
    for (int j = 0; j < 8; ++j) { const int n = nn + 8 * j; const LAS float* s = scr + (8 * c) * 65 + n;
        u32x4 o; o.x = cvtpk(s[0], s[65]); o.y = cvtpk(s[2 * 65], s[3 * 65]); o.z = cvtpk(s[4 * 65], s[5 * 65]); o.w = cvtpk(s[6 * 65], s[7 * 65]);
        *(u32x4*)(WT + (size_t)(drow0 + n) * K + k0 + 8 * c) = o; }
    asm volatile("s_waitcnt lgkmcnt(0)" ::: "memory");
}

__device__ __forceinline__ float quant_row_i8(const f32x4 (&o)[8], signed char* dst, int lane) {
    float am = 0.f;
#pragma unroll
    for (int j = 0; j < 8; ++j) am = fmaxf(fmaxf(am, fmaxf(fabsf(o[j][0]), fabsf(o[j][1]))), fmaxf(fabsf(o[j][2]), fabsf(o[j][3])));
#pragma unroll
    for (int off = 1; off < 64; off <<= 1) am = fmaxf(am, __shfl_xor(am, off));
    const float inv = am > 0.f ? 127.f / am : 0.f;
#pragma unroll
    for (int j = 0; j < 8; ++j) { const int b0 = (int)__builtin_rintf(o[j][0] * inv), b1 = (int)__builtin_rintf(o[j][1] * inv), b2 = (int)__builtin_rintf(o[j][2] * inv), b3 = (int)__builtin_rintf(o[j][3] * inv);
        ((unsigned*)dst)[64 * j + lane] = (unsigned)(b0 & 255) | ((unsigned)(b1 & 255) << 8) | ((unsigned)(b2 & 255) << 16) | ((unsigned)(b3 & 255) << 24); }
    return am * (1.f / 127.f);
}
__device__ __forceinline__ void quant_hidden_rows(bf16_t* HM, const unsigned* rmx, float* hqs, int rows, int gw, int NGW, int lane) {
    for (int row = gw; row < rows; row += NGW) {
        const float am = __uint_as_float(rmx[row]); const float inv = am > 0.f ? 127.f / am : 0.f;
        const u32x4* src = (const u32x4*)(HM + (size_t)row * DFF); u32x2* dst = (u32x2*)(HM + (size_t)row * DFF);
        u32x4 v[11];
#pragma unroll
        for (int i = 0; i < 11; ++i) v[i] = src[lane + 64 * i];
#pragma unroll
        for (int i = 0; i < 11; ++i) { unsigned o[2];
#pragma unroll
            for (int h = 0; h < 2; ++h) { const unsigned w0 = v[i][2 * h], w1 = v[i][2 * h + 1];
                int b0 = (int)__builtin_rintf(bf_lo(w0) * inv), b1 = (int)__builtin_rintf(bf_hi(w0) * inv), b2 = (int)__builtin_rintf(bf_lo(w1) * inv), b3 = (int)__builtin_rintf(bf_hi(w1) * inv);
                b0 = b0 > 127 ? 127 : (b0 < -127 ? -127 : b0); b1 = b1 > 127 ? 127 : (b1 < -127 ? -127 : b1); b2 = b2 > 127 ? 127 : (b2 < -127 ? -127 : b2); b3 = b3 > 127 ? 127 : (b3 < -127 ? -127 : b3);
                o[h] = (unsigned)(b0 & 255) | ((unsigned)(b1 & 255) << 8) | ((unsigned)(b2 & 255) << 16) | ((unsigned)(b3 & 255) << 24); }
            dst[lane + 64 * i] = (u32x2){o[0], o[1]}; }
        if (lane == 0) hqs[row] = am * (1.f / 127.f);
    }
}
__device__ __forceinline__ void sincos_d(double a, float& c, float& s) {
    const double TWO_PI = 6.283185307179586476925286766559;
    const double n = __builtin_rint(a / TWO_PI); const double r = a - n * TWO_PI; const double r2 = r * r;
    double sc = 1.0, ss = 1.0;
    sc = 1.0; ss = 1.0;
#pragma unroll
    for (int k = 13; k >= 1; --k) { ss = 1.0 - r2 / (double)((2 * k) * (2 * k + 1)) * ss; sc = 1.0 - r2 / (double)((2 * k - 1) * (2 * k)) * sc; }
    c = (float)sc; s = (float)(r * ss);
}

constexpr int PH_P0 = 0, PH_L0 = 1, PH_L1 = 12, PH_END = 23;
__host__ __device__ constexpr bool phase_valid(int p) { return p >= 0 && p < PH_END && !(p == 10 || p == 11); }
typedef const __attribute__((address_space(4))) Args* CArgs;
__device__ __forceinline__ void strip_k2048(const float* __restrict__ W, int N, int n0, signed char* __restrict__ W8, float* __restrict__ wsc, int drow0, LAS unsigned char* lds, int tid, float wmul = 1.f) {
    constexpr int SP = 4112;
    const int lane = tid & 63, wave = tid >> 6;
    LAS unsigned char* img = lds;
    LAS float* red2 = (LAS float*)(lds + 32 * SP);
    LAS float* scl2 = red2 + 256;
    const int kp = lane >> 3, c4 = (lane & 7) * 4;
    f32x4 mx = {0.f, 0.f, 0.f, 0.f};
#pragma unroll 8
    for (int it = 0; it < 16; ++it) { const int k = 256 * wave + 16 * it + 2 * kp;
        const f32x4 a = __builtin_nontemporal_load((const f32x4*)(W + (size_t)k * N + n0 + c4)), bq = __builtin_nontemporal_load((const f32x4*)(W + (size_t)(k + 1) * N + n0 + c4));
#pragma unroll
        for (int i = 0; i < 4; ++i) { mx[i] = fmaxf(mx[i], fmaxf(fabsf(a[i]), fabsf(bq[i]))); *(LAS unsigned*)(img + (c4 + i) * SP + k * 2) = cvtpk(a[i], bq[i]); } }
#pragma unroll
    for (int i = 0; i < 4; ++i) { mx[i] = fmaxf(mx[i], __shfl_xor(mx[i], 8)); mx[i] = fmaxf(mx[i], __shfl_xor(mx[i], 16)); mx[i] = fmaxf(mx[i], __shfl_xor(mx[i], 32)); }
    if (lane < 8) { red2[wave * 32 + c4 + 0] = mx[0]; red2[wave * 32 + c4 + 1] = mx[1]; red2[wave * 32 + c4 + 2] = mx[2]; red2[wave * 32 + c4 + 3] = mx[3]; }
    __syncthreads();
    if (tid < 32) { float m = 0.f;
#pragma unroll
        for (int w = 0; w < 8; ++w) m = fmaxf(m, red2[w * 32 + tid]);
        scl2[tid] = m > 0.f ? 127.f / m : 0.f; wsc[drow0 + tid] = m * (1.f / 127.f) * wmul; }
    __syncthreads();
#pragma unroll 2
    for (int q = 0; q < 8; ++q) { const int p = tid + 512 * q, n = p >> 7, ch = p & 127; const float inv = scl2[n];
        const u32x4 w0 = *(const LAS u32x4*)(img + n * SP + ch * 32), w1 = *(const LAS u32x4*)(img + n * SP + ch * 32 + 16);
        unsigned o[4];
#pragma unroll
        for (int h = 0; h < 2; ++h) { const unsigned d0 = h == 0 ? w0.x : w0.z, d1 = h == 0 ? w0.y : w0.w, e0 = h == 0 ? w1.x : w1.z, e1 = h == 0 ? w1.y : w1.w;
            const int b0 = (int)__builtin_rintf(bf_lo(d0) * inv), b1 = (int)__builtin_rintf(bf_hi(d0) * inv), b2 = (int)__builtin_rintf(bf_lo(d1) * inv), b3 = (int)__builtin_rintf(bf_hi(d1) * inv);
            const int g0 = (int)__builtin_rintf(bf_lo(e0) * inv), g1 = (int)__builtin_rintf(bf_hi(e0) * inv), g2 = (int)__builtin_rintf(bf_lo(e1) * inv), g3 = (int)__builtin_rintf(bf_hi(e1) * inv);
            o[h] = (unsigned)(b0 & 255) | ((unsigned)(b1 & 255) << 8) | ((unsigned)(b2 & 255) << 16) | ((unsigned)(b3 & 255) << 24);
            o[2 + h] = (unsigned)(g0 & 255) | ((unsigned)(g1 & 255) << 8) | ((unsigned)(g2 & 255) << 16) | ((unsigned)(g3 & 255) << 24); }
        *(u32x4*)(W8 + (size_t)(drow0 + n) * DM + ch * 16) = (u32x4){o[0], o[1], o[2], o[3]}; }
    __syncthreads();
}
__device__ __forceinline__ void strip_k5632(const float* __restrict__ W, int n0, signed char* __restrict__ W8, float* __restrict__ wsc, LAS unsigned char* lds, int tid) {
    constexpr int N = DM, KT = 11, Kb = 512 * KT;
    const int lane = tid & 63, wave = tid >> 6;
    LAS float* scr = (LAS float*)(lds + wave * 16640);
    LAS float* red = (LAS float*)(lds + 8 * 16640);
    LAS float* scl = red + 512;
    const int r = lane >> 4, c4 = (lane & 15) * 4;
    f32x4 mx = {0.f, 0.f, 0.f, 0.f};
    { const int k0 = 64 * (KT * wave);
#pragma unroll
        for (int i = 0; i < 16; ++i) { const f32x4 v = __builtin_nontemporal_load((const f32x4*)(W + (size_t)(k0 + 4 * i + r) * N + n0 + c4));
            mx[0] = fmaxf(mx[0], fabsf(v[0])); mx[1] = fmaxf(mx[1], fabsf(v[1])); mx[2] = fmaxf(mx[2], fabsf(v[2])); mx[3] = fmaxf(mx[3], fabsf(v[3])); } }
#pragma unroll
    for (int i = 0; i < 4; ++i) { mx[i] = fmaxf(mx[i], __shfl_xor(mx[i], 16)); mx[i] = fmaxf(mx[i], __shfl_xor(mx[i], 32)); }
    if (lane < 16) { red[wave * 64 + c4 + 0] = mx[0]; red[wave * 64 + c4 + 1] = mx[1]; red[wave * 64 + c4 + 2] = mx[2]; red[wave * 64 + c4 + 3] = mx[3]; }
    __syncthreads();
    if (tid < 64) { float m = 0.f;
#pragma unroll
        for (int w = 0; w < 8; ++w) m = fmaxf(m, red[w * 64 + tid]);
        scl[tid] = m > 0.f ? 32.f / m : 1.f; wsc[n0 + tid] = m > 0.f ? m * (1.f / 32.f) : 1.f; }
    __syncthreads();
    for (int t = 0; t < KT; ++t) { const int k0 = 64 * (KT * wave + t);
        f32x4 v[16];
#pragma unroll
        for (int i = 0; i < 16; ++i) v[i] = __builtin_nontemporal_load((const f32x4*)(W + (size_t)(k0 + 4 * i + r) * N + n0 + c4));
#pragma unroll
        for (int i = 0; i < 16; ++i) { LAS float* sp = scr + (4 * i + r) * 65 + c4; sp[0] = v[i][0]; sp[1] = v[i][1]; sp[2] = v[i][2]; sp[3] = v[i][3]; }
        asm volatile("s_waitcnt lgkmcnt(0)" ::: "memory");
        const int c = lane & 3, nn = lane >> 2;
#pragma unroll
        for (int j = 0; j < 4; ++j) { const int n = nn + 16 * j; const float inv = scl[n]; const LAS float* sp = scr + (16 * c) * 65 + n;
            unsigned o[4];
#pragma unroll
            for (int q = 0; q < 4; ++q) { unsigned w = 0u;
                const float x0 = __builtin_amdgcn_fmed3f(sp[(4 * q + 0) * 65] * inv, -440.f, 440.f), x1 = __builtin_amdgcn_fmed3f(sp[(4 * q + 1) * 65] * inv, -440.f, 440.f);
                const float x2 = __builtin_amdgcn_fmed3f(sp[(4 * q + 2) * 65] * inv, -440.f, 440.f), x3 = __builtin_amdgcn_fmed3f(sp[(4 * q + 3) * 65] * inv, -440.f, 440.f);
                w = __builtin_amdgcn_cvt_pk_fp8_f32(x0, x1, w, false); w = __builtin_amdgcn_cvt_pk_fp8_f32(x2, x3, w, true); o[q] = w; }
            *(u32x4*)(W8 + (size_t)(n0 + n) * Kb + k0 + 16 * c) = (u32x4){o[0], o[1], o[2], o[3]}; }
        asm volatile("s_waitcnt lgkmcnt(0)" ::: "memory");
    }
    __syncthreads();
}
constexpr float GLU_GATE_MUL = 1.4426950408889634f, GLU_UP_MUL = 4.f / 1.4426950408889634f;
constexpr int NSA_DN = 32, NSA_IN = 288, NSA_OUT = 128, NSA_GU = 352, NSA = NSA_DN + NSA_IN + NSA_OUT + NSA_GU;
constexpr int NSE_GU = 16 * 176, NSE_DN = 8 * 32, NSE = NSE_GU + NSE_DN;
__device__ __forceinline__ void do_strip_A(CArgs ap, int st, LAS unsigned char* lds, int tid) {
    unsigned char* ws = ap->ws;
    if (st < NSA_DN) { strip_k5632(ap->in[I_FFD], 64 * st, (signed char*)(ws + WS_FF2), (float*)(ws + WS_WSCD), lds, tid); return; }
    st -= NSA_DN;
    if (st < NSA_IN) { const int l = st / 144, sb = st % 144;
        strip_k2048(ap->in[I_WIN] + (size_t)l * DM * DIN, DIN, 32 * sb, (signed char*)(ws + WS_WIN + (size_t)l * (SZ_WIN / 2)), (float*)(ws + WS_WSCIN) + l * DIN, 32 * sb, lds, tid); return; }
    st -= NSA_IN;
    if (st < NSA_OUT) { const int l = st / 64, sb = st % 64;
        strip_k2048(ap->in[I_WOUT] + (size_t)l * DM * DM, DM, 32 * sb, (signed char*)(ws + WS_WOUT + (size_t)l * (SZ_WOUT / 2)), (float*)(ws + WS_WSCO) + l * DM, 32 * sb, lds, tid); return; }
    st -= NSA_OUT;
    { const int up = st / 176, sb = st % 176, n0 = 32 * sb;
      strip_k2048(ap->in[up ? I_FFU : I_FFG], DFF, n0, (signed char*)(ws + WS_FF1), (float*)(ws + WS_WSC1), (n0 / 128) * 256 + (n0 % 128) + (up ? 128 : 0), lds, tid, up ? GLU_UP_MUL : GLU_GATE_MUL); }
}
__device__ __forceinline__ void do_strip_E(CArgs ap, int st, LAS unsigned char* lds, int tid) {
    unsigned char* ws = ap->ws;
    if (st < NSE_GU) { const int mat = st / 176, sb = st % 176, e = mat >> 1, up = mat & 1, n0 = 32 * sb;
        strip_k2048(ap->in[up ? I_EXU : I_EXG] + (size_t)e * DM * DFF, DFF, n0, (signed char*)(ws + WS_EX1 + (size_t)e * (SZ_FF1 / 2)), (float*)(ws + WS_WSCX + (size_t)e * 2 * DFF * 4),
                    (n0 / 128) * 256 + (n0 % 128) + (up ? 128 : 0), lds, tid, up ? GLU_UP_MUL : GLU_GATE_MUL); return; }
    st -= NSE_GU;
    { const int e = st / 32, sb = st % 32;
      strip_k5632(ap->in[I_EXD] + (size_t)e * DFF * DM, 64 * sb, (signed char*)(ws + WS_EX2 + (size_t)e * (SZ_FF2 / 2)), (float*)(ws + WS_WSCD) + (1 + e) * DM, lds, tid); }
}
__device__ __forceinline__ void pull_strips_E(CArgs ap, unsigned* ctr, int lo, int hi, LAS unsigned char* lds, int tid) {
    LAS int* nxt = (LAS int*)(lds + 8 * 16640 + 2048 + 256);
    for (;;) {
        if (tid == 0) nxt[0] = (int)atomicAdd(ctr, 1u);
        __syncthreads();
        const int st = lo + nxt[0];
        __syncthreads();
        if (st >= hi) break;
        do_strip_E(ap, st, lds, tid);
    }
}
constexpr int NRNG = 7;
#ifndef BG_SPLIT
#define BG_SPLIT 1
#endif
#ifndef BG_N0
#define BG_N0 0
#define BG_N1 0
#define BG_N2 0
#define BG_N3 0
#define BG_N4 0
#endif
constexpr int BG_S1 = BG_N0, BG_S2 = BG_S1 + BG_N1, BG_S4 = BG_S2 + BG_N2, BG_S5 = BG_S4 + BG_N4;
__host__ __device__ constexpr int rng_lo(int i) { return i == 0 ? 0 : i == 1 ? BG_S1 : i == 2 ? BG_S2 : i == 3 ? NSE_GU : i == 4 ? BG_S4 : i == 5 ? BG_S5 : NSE_GU + BG_N3; }
__host__ __device__ constexpr int rng_hi(int i) { return i == 0 ? BG_S1 : i == 1 ? BG_S2 : i == 2 ? BG_S4 : i == 3 ? NSE_GU + BG_N3 : i == 4 ? BG_S5 : i == 5 ? NSE_GU : NSE; }
#define BG_PULL(R) pull_strips_E(ap, (unsigned*)(ws + WS_CTL) + 8193 + (R), rng_lo(R), rng_hi(R), lds, tid)
#ifndef DBG_MASK
#define DBG_MASK 0xFFFFFFFFu
#endif
#define IN(k) (((DBG_MASK >> (k)) & 1u) && lo <= (k) && (k) < hi)
#define SEAM(k) do { if (hi > (k) + 1) xcd_barrier(bar); } while (0)
#define REP(k) for (int rep_ = 0; rep_ < ((PROBE_DUP) == (k) ? 2 : 1); ++rep_)
#define PH_ENTER() CArgs ap = (CArgs)__builtin_amdgcn_kernarg_segment_ptr(); asm volatile("" : "+s"(ap)); unsigned char* ws = ap->ws; (void)ws; \
    int tid = threadIdx.x; asm volatile("" : "+v"(tid)); const int lane = tid & 63, wave = __builtin_amdgcn_readfirstlane(tid >> 6); (void)lane; (void)wave; \
    const int gw = vcu * NWAVES + wave, NGW = G * NWAVES; (void)gw; (void)NGW; \
    float* ADA = (float*)(ws + WS_ADA); float* ROPE = (float*)(ws + WS_ROPE); float* LAM = (float*)(ws + WS_LAM); \
    int* CCNT = (int*)(ws + WS_CCNT); unsigned* TOKE = (unsigned*)(ws + WS_TOKE); float* TOKW = (float*)(ws + WS_TOKW); int* TOKP = (int*)(ws + WS_TOKP); \
    bf16_t* H = (bf16_t*)(ws + WS_H); bf16_t* U = (bf16_t*)(ws + WS_U); bf16_t* OC = (bf16_t*)(ws + WS_OC); bf16_t* MIX = (bf16_t*)(ws + WS_MIX); \
    bf16_t* XL = (bf16_t*)(ws + WS_XL); bf16_t* HMID = (bf16_t*)(ws + WS_HMID); bf16_t* HS = (bf16_t*)(ws + WS_HS); bf16_t* Y = (bf16_t*)(ws + WS_Y); \
    const float* ada_l = ADA + (size_t)l * 3 * ADA_N; float* HSC = (float*)(ws + WS_HSC); float* HSS = (float*)(ws + WS_HSS); (void)HSC; (void)HSS; \
    (void)ROPE; (void)LAM; (void)CCNT; (void)TOKE; (void)TOKW; (void)TOKP; (void)H; (void)U; (void)OC; (void)MIX; (void)XL; (void)HMID; (void)HS; (void)Y; (void)ada_l
template <int l>
__device__ __forceinline__ void run_layer(LAS unsigned char* lds, const XcdBarrier& bar, int lo, int hi, int G, int bx, int vcu) {
    {
        const int PB = l == 0 ? PH_L0 : PH_L1;
        REP(PB + 0) if (IN(PB + 0)) {
            PH_ENTER();
            const float* gn = ap->in[I_GN1] + l * DM;
            for (int row = gw; row < MALL; row += NGW) {
                const int b = row / SEG, rr = row - b * SEG; const bool isctx = rr < CTXL;
                const float* xr = isctx ? ap->in[I_CTX] + ((size_t)b * CTXL + rr) * DM : ap->in[I_X] + ((size_t)b * SEQ + rr - CTXL) * DM;
                const bf16_t* xb = XL + (size_t)row * DM;
                const float* shp = ada_l + (isctx ? 2 : b) * ADA_N; const float* scp = shp + DM;
                f32x4 v[8]; float ss = 0.f;
#pragma unroll
                for (int j = 0; j < 8; ++j) { if constexpr (l == 0) v[j] = ((const f32x4*)xr)[64 * j + lane]; else v[j] = ldx4(xb + 4 * (64 * j + lane)); ss += (v[j][0] * v[j][0] + v[j][1] * v[j][1]) + (v[j][2] * v[j][2] + v[j][3] * v[j][3]); }
                const float rstd = 1.f / sqrtf(wave_sum(ss) * (1.f / DM) + NORM_EPS);
#pragma unroll
                for (int j = 0; j < 8; ++j) { const f32x4 g4 = ((const f32x4*)gn)[64 * j + lane], s4 = ((const f32x4*)shp)[64 * j + lane], c4 = ((const f32x4*)scp)[64 * j + lane];
                    v[j] = v[j] * rstd * g4 * (c4 + 1.f) + s4; }
                const float sc = quant_row_i8(v, (signed char*)H + (size_t)row * DM, lane);
                if (lane == 0) HSC[row] = sc;
            }
            SEAM(PB + 0);
        }
        REP(PB + 1) if (IN(PB + 1)) {
            PH_ENTER();
            if (BG_SPLIT && G == 256 && bx >= 240) { BG_PULL(l == 0 ? 0 : 4); }
            else {
            pg8::Gemm g{H, (const bf16_t*)(ws + WS_WIN + (size_t)l * (SZ_WIN / 2)), DM / 2, DM / 2};
            pg8::TileSched S; S.init(MALL / 256, DIN / 256, (BG_SPLIT && G == 256) ? 240 : G, bx, 0, nullptr);
            pg8::EpiInI8 E{U, ROPE, HSC, (const float*)(ws + WS_WSCIN) + l * DIN, ws + WS_VT8};
            pg8::gemm_phase<pg8::EpiInI8, true, 1>(lds, g, S, E);
            }
            SEAM(PB + 1);
        }
        REP(PB + 2) if (IN(PB + 2)) {
            PH_ENTER();
#ifndef DBG_NOBIG
            for (int rp_ = 0; rp_ < ((PROBE_DUP) == 100 + l ? 2 : 1); ++rp_)
            for (int id = vcu; id < 768; id += G) {
                const int combo = id >> 5, qb = id & 31, b = combo / 12, rem = combo % 12, h = rem >> 1, c = rem & 1;
                const unsigned char* seg = (const unsigned char*)U + (size_t)b * SEG * UROWB + Q8_OFF;
                att::attn_unit<128, false>(seg + (size_t)(CTXL + qb * 256) * UROWB + QB_Q + h * 128 + c * 64, seg + QB_K + h * 128 + c * 64, ws + WS_VT8 + ((size_t)b * 1024 + h * 128) * SEG,
                                           132, CTXL, false, 0, 0.f, OC + ((size_t)c * MALL + (size_t)b * SEG + CTXL + qb * 256) * 768 + h * 128, 768, lds);
            }
#endif
#ifndef DBG_NOSWA
            for (int rp_ = 0; rp_ < ((PROBE_DUP) == 102 + l ? 2 : 1); ++rp_)
            for (int s = vcu; s < 768; s += G) {
                const int bh = s >> 5, qb = s & 31, b = bh / 12, qh = bh % 12, kvh = qh / 3, q0 = qb * 256;
                const int ks = q0 - 128 < 0 ? 0 : q0 - 128, ke = q0 + 384 > SEQ ? SEQ : q0 + 384;
                const unsigned char* seg = (const unsigned char*)U + (size_t)b * SEG * UROWB + Q8_OFF;
                att::attn_unit<64, true>(seg + (size_t)(CTXL + q0) * UROWB + QB_CQ + qh * 64, seg + QB_CK + kvh * 64, ws + WS_VT8 + ((size_t)b * 1024 + 768 + kvh * 64) * SEG,
                                         4 + (ke - ks) / 64, CTXL + ks, true, q0 - ks, ap->in[I_SINK][l * 12 + qh],
                                         MIX + ((size_t)b * SEG + CTXL + q0) * DM + MIX_SWA + qh * 64, DM, lds);
            }
#endif
#ifndef DBG_NOCONV
            for (int rp_ = 0; rp_ < ((PROBE_DUP) == 104 + l ? 2 : 1); ++rp_)
            for (int j = vcu; j < (l == 0 ? MALL / 16 : NTOK / 16); j += G) {
                const int row0 = l == 0 ? 16 * j : (j / 512) * SEG + CTXL + (j % 512) * 16;
                const int b = row0 / SEG, rr0 = row0 - b * SEG; const int seg_lo = rr0 < CTXL ? b * SEG : b * SEG + CTXL, seg_hi = rr0 < CTXL ? b * SEG + CTXL : (b + 1) * SEG;
                LAS float* Yl = (LAS float*)lds;
                LAS float* Ol = (LAS float*)(lds + 46 * 512 * 4);
                const int ch = tid, chp = (ch & ~31) + 8 * ((ch >> 2) & 3) + 4 * ((ch >> 4) & 1) + (ch & 3);
#pragma unroll
                for (int tb = 0; tb < 46; tb += 23) {
                    unsigned short av[23], gv[23];
#pragma unroll
                    for (int t = 0; t < 23; ++t) { const int row = row0 - 15 + tb + t; const int rc = row < seg_lo ? seg_lo : (row >= seg_hi ? seg_hi - 1 : row);
                        av[t] = U[(size_t)rc * DIN + chp]; gv[t] = U[(size_t)rc * DIN + 512 + chp]; }
#pragma unroll
                    for (int t = 0; t < 23; ++t) { const int row = row0 - 15 + tb + t; const float a = __uint_as_float((unsigned)av[t] << 16), gt = __uint_as_float((unsigned)gv[t] << 16);
                        Yl[(tb + t) * 512 + ch] = (row >= seg_lo && row < seg_hi) ? a * fsigmoid(gt) : 0.f; }
                }
                float wk[31];
#pragma unroll
                for (int k = 0; k < 31; ++k) wk[k] = ap->in[I_WDW][(size_t)l * 31 * 512 + k * 512 + ch];
                const float bias = ap->in[I_BDW][l * 512 + ch];
                float oacc[16];
#pragma unroll
                for (int t = 0; t < 16; ++t) oacc[t] = bias;
                asm volatile("s_waitcnt lgkmcnt(0)" ::: "memory");
#pragma unroll
                for (int sidx = 0; sidx < 46; ++sidx) { const float yv = Yl[sidx * 512 + ch];
#pragma unroll
                    for (int t = 0; t < 16; ++t) { const int k = sidx - t; if (k >= 0 && k < 31) oacc[t] += wk[k] * yv; } }
#pragma unroll
                for (int t = 0; t < 16; ++t) Ol[t * 512 + ch] = oacc[t];
                __syncthreads();
                for (int t = wave * 2; t < wave * 2 + 2; ++t) {
                    const f32x4 v0 = *(const LAS f32x4*)(Ol + t * 512 + 8 * lane), v1 = *(const LAS f32x4*)(Ol + t * 512 + 8 * lane + 4);
                    const float mean = wave_sum((v0[0] + v0[1]) + (v0[2] + v0[3]) + (v1[0] + v1[1]) + (v1[2] + v1[3])) * (1.f / 512.f);
                    const f32x4 d0 = v0 - mean, d1 = v1 - mean;
                    const float var = wave_sum((d0[0] * d0[0] + d0[1] * d0[1]) + (d0[2] * d0[2] + d0[3] * d0[3]) + (d1[0] * d1[0] + d1[1] * d1[1]) + (d1[2] * d1[2] + d1[3] * d1[3])) * (1.f / 512.f);
                    const float rstd = 1.f / sqrtf(var + NORM_EPS);
                    const f32x4 g0 = *(const f32x4*)(ap->in[I_LNG] + l * 512 + 8 * lane), g1 = *(const f32x4*)(ap->in[I_LNG] + l * 512 + 8 * lane + 4);
                    const f32x4 b0 = *(const f32x4*)(ap->in[I_LNB] + l * 512 + 8 * lane), b1 = *(const f32x4*)(ap->in[I_LNB] + l * 512 + 8 * lane + 4);
                    const f32x4 y0 = d0 * rstd * g0 + b0, y1 = d1 * rstd * g1 + b1;
                    u32x4 w; w.x = cvtpk(fsilu(y0[0]), fsilu(y0[1])); w.y = cvtpk(fsilu(y0[2]), fsilu(y0[3])); w.z = cvtpk(fsilu(y1[0]), fsilu(y1[1])); w.w = cvtpk(fsilu(y1[2]), fsilu(y1[3]));
                    *(u32x4*)(MIX + (size_t)(row0 + t) * DM + 8 * lane) = w;
                }
                __syncthreads();
            }
#endif
#ifndef DBG_NOCTX
            if (l == 0) {
                for (int j = (vcu + G - 32 % G) % G; j < 24; j += G) {
                    const int b = j / 12, rem = j % 12, h = rem >> 1, c = rem & 1; const unsigned char* seg = (const unsigned char*)U + (size_t)b * SEG * UROWB + Q8_OFF;
                    att::attn_unit<128, false>(seg + QB_Q + h * 128 + c * 64, seg + QB_K + h * 128 + c * 64, ws + WS_VT8 + ((size_t)b * 1024 + h * 128) * SEG,
                                               4, CTXL, false, 0, 0.f, OC + ((size_t)c * MALL + (size_t)b * SEG) * 768 + h * 128, 768, lds);
                }
                for (int j = (vcu + G - 64 % G) % G; j < 24; j += G) {
                    const int b = j / 12, qh = j % 12, kvh = qh / 3; const unsigned char* seg = (const unsigned char*)U + (size_t)b * SEG * UROWB + Q8_OFF;
                    att::attn_unit<64, true>(seg + QB_CQ + qh * 64, seg + QB_CK + kvh * 64, ws + WS_VT8 + ((size_t)b * 1024 + 768 + kvh * 64) * SEG,
                                             4, CTXL, false, 0, ap->in[I_SINK][l * 12 + qh], MIX + (size_t)b * SEG * DM + MIX_SWA + qh * 64, DM, lds);
                }
            }
#endif
            SEAM(PB + 2);
        }
        REP(PB + 3) if (IN(PB + 3)) {
            PH_ENTER();
            const float lam = LAM[l]; const float post = 1.f - (l == 0 ? 0.2f : (float)(0.8 - 0.6 * 0.74081822068171786607));
            const float* gs = ap->in[I_GSUB] + l * 128;
            float* MXS = (float*)(ws + WS_MXS);
            for (int row = gw; row < MALL; row += NGW) {
                if (l == 1 && (row % SEG) < CTXL) continue;
                const u32x4 cvp = ((const u32x4*)(MIX + (size_t)row * DM))[lane];
                u32x2 swp[3];
#pragma unroll
                for (int j = 0; j < 3; ++j) swp[j] = *(const u32x2*)(MIX + (size_t)row * DM + MIX_SWA + 4 * (64 * j + lane));
                const bf16_t* o1 = OC + (size_t)row * 768; const bf16_t* o2 = OC + ((size_t)MALL + row) * 768;
                f32x4 dv[3];
#pragma unroll
                for (int j = 0; j < 3; ++j) { const int q = 64 * j + lane; const f32x4 a = ldx4(o1 + 4 * q), bq = ldx4(o2 + 4 * q); const f32x4 d = a - bq * lam;
                    float ss = (d[0] * d[0] + d[1] * d[1]) + (d[2] * d[2] + d[3] * d[3]);
                    ss += __shfl_xor(ss, 1); ss += __shfl_xor(ss, 2); ss += __shfl_xor(ss, 4); ss += __shfl_xor(ss, 8); ss += __shfl_xor(ss, 16);
                    const float rs = post / sqrtf(ss * (1.f / 128.f) + NORM_EPS);
                    const f32x4 g4 = *(const f32x4*)(gs + 4 * (lane & 31)); dv[j] = d * rs * g4; }
                f32x4 c0 = {bf_lo(cvp.x), bf_hi(cvp.x), bf_lo(cvp.y), bf_hi(cvp.y)}, c1 = {bf_lo(cvp.z), bf_hi(cvp.z), bf_lo(cvp.w), bf_hi(cvp.w)};
                f32x4 sv[3];
#pragma unroll
                for (int j = 0; j < 3; ++j) sv[j] = (f32x4){bf_lo(swp[j].x), bf_hi(swp[j].x), bf_lo(swp[j].y), bf_hi(swp[j].y)};
                float am = 0.f;
#pragma unroll
                for (int i = 0; i < 4; ++i) { am = fmaxf(am, fmaxf(fabsf(c0[i]), fabsf(c1[i])));
#pragma unroll
                    for (int j = 0; j < 3; ++j) am = fmaxf(am, fmaxf(fabsf(dv[j][i]), fabsf(sv[j][i]))); }
#pragma unroll
                for (int off = 1; off < 64; off <<= 1) am = fmaxf(am, __shfl_xor(am, off));
                const float inv = am > 0.f ? 127.f / am : 0.f;
                signed char* dst = (signed char*)(MIX + (size_t)row * DM);
#define Q4(v) ((unsigned)((int)__builtin_rintf((v)[0] * inv) & 255) | ((unsigned)((int)__builtin_rintf((v)[1] * inv) & 255) << 8) | ((unsigned)((int)__builtin_rintf((v)[2] * inv) & 255) << 16) | ((unsigned)((int)__builtin_rintf((v)[3] * inv) & 255) << 24))
                *(u32x2*)(dst + 8 * lane) = (u32x2){Q4(c0), Q4(c1)};
#pragma unroll
                for (int j = 0; j < 3; ++j) { *(unsigned*)(dst + MIX_DIFF + 4 * (64 * j + lane)) = Q4(dv[j]); *(unsigned*)(dst + MIX_SWA + 4 * (64 * j + lane)) = Q4(sv[j]); }
#undef Q4
                if (lane == 0) MXS[row] = am * (1.f / 127.f);
            }
            SEAM(PB + 3);
        }
        REP(PB + 4) if (IN(PB + 4)) {
            PH_ENTER();
            pg8::Gemm g{MIX, (const bf16_t*)(ws + WS_WOUT + (size_t)l * (SZ_WOUT / 2)), DM / 2, DM};
            const bool bgmode = (BG_SPLIT && l == 0 && G == 256);
            if (bgmode && bx >= 176) { BG_PULL(1); }
            else {
            pg8::TileSched S; S.init(l == 0 ? MALL / 256 : NTOK / 256, DM / 256, bgmode ? 176 : G, bx, l == 0 ? 0 : 1, nullptr);
            pg8::EpiResI8 E{XL, ada_l, 2 * DM, (const float*)(ws + WS_MXS), (const float*)(ws + WS_WSCO) + l * DM, ap->in[I_X], ap->in[I_CTX], l == 0 ? 1 : 0};
            pg8::gemm_phase<pg8::EpiResI8, true, 1>(lds, g, S, E);
            }
            SEAM(PB + 4);
        }
        if constexpr (l == 0) {
            REP(PB + 5) if (IN(PB + 5)) {
            PH_ENTER();
                const float* gn = ap->in[I_GN2] + l * DM;
                for (int row = gw; row < MALL; row += NGW) {
                    const int b = row / SEG, rr = row - b * SEG; const bool isctx = rr < CTXL;
                    const bf16_t* xr = XL + (size_t)row * DM;
                    const float* shp = ada_l + (isctx ? 2 : b) * ADA_N + 3 * DM; const float* scp = shp + DM;
                    f32x4 v[8]; float ss = 0.f;
#pragma unroll
                    for (int j = 0; j < 8; ++j) { v[j] = ldx4(xr + 4 * (64 * j + lane)); ss += (v[j][0] * v[j][0] + v[j][1] * v[j][1]) + (v[j][2] * v[j][2] + v[j][3] * v[j][3]); }
                    const float rstd = 1.f / sqrtf(wave_sum(ss) * (1.f / DM) + NORM_EPS);
#pragma unroll
                    for (int j = 0; j < 8; ++j) { const f32x4 g4 = ((const f32x4*)gn)[64 * j + lane], s4 = ((const f32x4*)shp)[64 * j + lane], c4 = ((const f32x4*)scp)[64 * j + lane];
                        v[j] = v[j] * rstd * g4 * (c4 + 1.f) + s4; }
                    const float sc = quant_row_i8(v, (signed char*)H + (size_t)row * DM, lane);
                    if (lane == 0) HSC[row] = sc;
                }
                SEAM(PB + 5);
            }
            REP(PB + 6) if (IN(PB + 6)) {
            PH_ENTER();
                pg8::Gemm g{H, (const bf16_t*)(ws + WS_FF1), DM / 2, DM / 2};
                if (BG_SPLIT && G == 256 && bx >= 248) { BG_PULL(2); }
                else {
                pg8::TileSched S; S.init(MALL / 256, 2 * DFF / 256, (BG_SPLIT && G == 256) ? 248 : G, bx, 0, nullptr);
                pg8::EpiGluI8 E{(unsigned char*)HMID, HSC, (const float*)(ws + WS_WSC1)};
                pg8::gemm_phase<pg8::EpiGluI8, true, 1>(lds, g, S, E);
                }
                SEAM(PB + 6);
            }
            REP(PB + 8) if (IN(PB + 8)) {
            PH_ENTER();
                pg8::Gemm g{HMID, (const bf16_t*)(ws + WS_FF2), DFF / 2, DFF / 2};
                if (BG_SPLIT && G == 256 && bx >= 176) { BG_PULL(3); }
                else {
                pg8::TileSched S; S.init(MALL / 256, DM / 256, (BG_SPLIT && G == 256) ? 176 : G, bx, 0, nullptr);
                pg8::EpiResF8 E{XL, ada_l, 5 * DM, (const float*)(ws + WS_WSCD)};
                pg8::gemm_phase<pg8::EpiResF8, true, 2>(lds, g, S, E);
                }
                SEAM(PB + 8);
            }
        } else {
            REP(PB + 5) if (IN(PB + 5)) {
            PH_ENTER();
                { BG_PULL(3); BG_PULL(6); BG_PULL(0); BG_PULL(1); BG_PULL(2); BG_PULL(4); BG_PULL(5); }
                __syncthreads();
                LAS float* wrT = (LAS float*)lds;
                LAS int* hist = (LAS int*)(lds + 8 * 2048 * 4);
                for (int i = tid; i < 8 * DM; i += 512) { const int e = i / DM, k = i % DM; wrT[i] = ap->in[I_WR][k * 8 + e]; }
                if (tid < 8) hist[tid] = 0;
                __syncthreads();
                const float* gn = ap->in[I_GN2] + l * DM;
                for (int ck = bx; ck < 256; ck += G) {
#pragma unroll 1
                    for (int ti = 0; ti < 8; ++ti) {
                        int lane = tid & 63; asm volatile("" : "+v"(lane));
                        const int tok = ck * 64 + wave * 8 + ti, b = tok / SEQ, row = tok + CTXL * (b + 1);
                        const bf16_t* xr = XL + (size_t)row * DM; const float* shp = ada_l + b * ADA_N + 3 * DM; const float* scp = shp + DM;
                        f32x4 v[8]; float ss = 0.f;
#pragma unroll
                        for (int j = 0; j < 8; ++j) { v[j] = ldx4(xr + 4 * (64 * j + lane)); ss += (v[j][0] * v[j][0] + v[j][1] * v[j][1]) + (v[j][2] * v[j][2] + v[j][3] * v[j][3]); }
                        const float rstd = 1.f / sqrtf(wave_sum(ss) * (1.f / DM) + NORM_EPS);
                        float lg[8];
#pragma unroll
                        for (int e = 0; e < 8; ++e) lg[e] = 0.f;
#pragma unroll
                        for (int j = 0; j < 8; ++j) { const f32x4 g4 = ((const f32x4*)gn)[64 * j + lane], s4 = ((const f32x4*)shp)[64 * j + lane], c4 = ((const f32x4*)scp)[64 * j + lane];
                            const f32x4 o = v[j] * rstd * g4 * (c4 + 1.f) + s4; v[j] = o;
#pragma unroll
                            for (int e = 0; e < 8; ++e) { const f32x4 wv = *(const LAS f32x4*)(wrT + e * DM + 4 * (64 * j + lane)); lg[e] += (o[0] * wv[0] + o[1] * wv[1]) + (o[2] * wv[2] + o[3] * wv[3]); } }
#pragma unroll
                        for (int e = 0; e < 8; ++e) lg[e] = wave_sum(lg[e]);
                        { const float sc = quant_row_i8(v, (signed char*)H + (size_t)row * DM, lane); if (lane == 0) HSC[row] = sc; }
                        int e0 = 0; float v0 = lg[0];
#pragma unroll
                        for (int e = 1; e < 8; ++e) if (lg[e] > v0) { v0 = lg[e]; e0 = e; }
                        int e1 = -1; float v1 = -3.0e38f;
#pragma unroll
                        for (int e = 0; e < 8; ++e) if (e != e0 && lg[e] > v1) { v1 = lg[e]; e1 = e; }
                        const float ex = expf(v1 - v0), w0 = 1.f / (1.f + ex), w1 = ex / (1.f + ex);
                        if (lane == 0) { TOKE[tok] = (unsigned)e0 | ((unsigned)e1 << 8); TOKW[2 * tok] = w0; TOKW[2 * tok + 1] = w1; atomicAdd((int*)&hist[e0], 1); atomicAdd((int*)&hist[e1], 1); }
                    }
                    __syncthreads();
                    if (tid < 8) { CCNT[ck * 8 + tid] = hist[tid]; hist[tid] = 0; }
                    __syncthreads();
                }
                SEAM(PB + 5);
            }
            LAS int* m_tot = (LAS int*)(lds + MISC_OFF + 256);
            LAS int* m_seg = m_tot + 8;
            LAS int* m_pre = m_seg + 8;
            LAS int* m_nt = m_pre + 8;
            LAS unsigned char* m_te = (LAS unsigned char*)(m_nt + 4);
            LAS int* m_part = (LAS int*)(lds + MISC_OFF + 1024);
            REP(PB + 6) if (IN(PB + 6)) {
            PH_ENTER();
                for (int ck = bx; ck < 256; ck += G) {
                    { const int e = tid & 7, cg = tid >> 3; int s = 0, sp = 0;
#pragma unroll
                      for (int q = 0; q < 4; ++q) { const int c = 4 * cg + q; const int v = CCNT[c * 8 + e]; s += v; if (c < ck) sp += v; }
                      m_part[cg * 8 + e] = s; m_part[512 + cg * 8 + e] = sp; }
                    __syncthreads();
                    if (tid < 8) { int s = 0, sp = 0; for (int q = 0; q < 64; ++q) { s += m_part[q * 8 + tid]; sp += m_part[512 + q * 8 + tid]; } m_tot[tid] = s; m_pre[tid] = sp; }
                    __syncthreads();
                    if (tid == 0) { int acc = 0; for (int e = 0; e < 8; ++e) { m_seg[e] = acc; acc += (m_tot[e] + 255) & ~255; }
                        LAS int* posl = (LAS int*)lds;
                        for (int i = 0; i < 64; ++i) { const int tok = ck * 64 + i; const unsigned ee = TOKE[tok]; const int e0 = ee & 255, e1 = ee >> 8;
                            const int p0 = m_seg[e0] + m_pre[e0]; m_pre[e0]++; const int p1 = m_seg[e1] + m_pre[e1]; m_pre[e1]++;
                            posl[2 * i] = p0; posl[2 * i + 1] = p1; TOKP[2 * tok] = p0; TOKP[2 * tok + 1] = p1; } }
                    __syncthreads();
                    { const LAS int* posl = (const LAS int*)lds;
                      for (int ti = 0; ti < 8; ++ti) { const int i = wave * 8 + ti, tok = ck * 64 + i, b = tok / SEQ, row = tok + CTXL * (b + 1);
                        const int p0 = posl[2 * i], p1 = posl[2 * i + 1];
                        const u32x4* src = (const u32x4*)((const signed char*)H + (size_t)row * DM); u32x4* d0 = (u32x4*)((signed char*)HS + (size_t)p0 * DM); u32x4* d1 = (u32x4*)((signed char*)HS + (size_t)p1 * DM);
#pragma unroll
                        for (int q = 0; q < 2; ++q) { const u32x4 v = src[64 * q + lane]; d0[64 * q + lane] = v; d1[64 * q + lane] = v; }
                        if (lane == 0) { const float sc = HSC[row]; HSS[p0] = sc; HSS[p1] = sc; } } }
                    __syncthreads();
                }
                SEAM(PB + 6);
            }
            if (IN(PB + 7) || IN(PB + 8) || IN(PB + 9)) {
                PH_ENTER();
                { const int e = tid & 7, cg = tid >> 3; int s = 0;
#pragma unroll
                  for (int q = 0; q < 4; ++q) s += CCNT[(4 * cg + q) * 8 + e];
                  m_part[cg * 8 + e] = s; }
                __syncthreads();
                if (tid < 8) { int s = 0; for (int q = 0; q < 64; ++q) s += m_part[q * 8 + tid]; m_tot[tid] = s; }
                __syncthreads();
                if (tid == 0) { int nt = 0; for (int e = 0; e < 8; ++e) { const int n = (m_tot[e] + 255) >> 8; for (int q = 0; q < n; ++q) m_te[nt + q] = (unsigned char)e; nt += n; } m_nt[0] = nt; }
                __syncthreads();
            }
            REP(PB + 7) if (IN(PB + 7)) {
            PH_ENTER();
                pg8::Gemm g{HS, (const bf16_t*)(ws + WS_EX1), DM / 2, DM / 2};
                pg8::TileSched S; S.init(m_nt[0], 2 * DFF / 256, G, bx, 2, m_te);
                pg8::EpiGluI8 E{(unsigned char*)HMID, HSS, (const float*)(ws + WS_WSCX)};
                pg8::gemm_phase<pg8::EpiGluI8, true, 1>(lds, g, S, E);
                SEAM(PB + 7);
            }
            REP(PB + 9) if (IN(PB + 9)) {
            PH_ENTER();
                pg8::Gemm g{HMID, (const bf16_t*)(ws + WS_EX2), DFF / 2, DFF / 2};
                pg8::TileSched S; S.init(m_nt[0], DM / 256, G, bx, 2, m_te);
                pg8::EpiBf16F8 E{Y, (const float*)(ws + WS_WSCD) + DM};
                pg8::gemm_phase<pg8::EpiBf16F8, true, 2>(lds, g, S, E);
                SEAM(PB + 9);
            }
            REP(PB + 10) if (IN(PB + 10)) {
            PH_ENTER();
                const float* gf = ap->in[I_GFIN];
                for (int tok = gw; tok < NTOK; tok += NGW) {
                    const int b = tok / SEQ, row = tok + CTXL * (b + 1);
                    const bf16_t* xr = XL + (size_t)row * DM; const float* gt = ada_l + b * ADA_N + 5 * DM;
                    const int p0 = TOKP[2 * tok], p1 = TOKP[2 * tok + 1]; const float w0 = TOKW[2 * tok], w1 = TOKW[2 * tok + 1];
                    const u32x2* y0 = (const u32x2*)(Y + (size_t)p0 * DM); const u32x2* y1 = (const u32x2*)(Y + (size_t)p1 * DM);
                    f32x4 v[8]; float ss = 0.f;
#pragma unroll
                    for (int j = 0; j < 8; ++j) { const f32x4 xv = ldx4(xr + 4 * (64 * j + lane)), g4 = ((const f32x4*)gt)[64 * j + lane]; const u32x2 a = y0[64 * j + lane], c = y1[64 * j + lane];
                        const f32x4 ya = {bf_lo(a.x), bf_hi(a.x), bf_lo(a.y), bf_hi(a.y)}, yc = {bf_lo(c.x), bf_hi(c.x), bf_lo(c.y), bf_hi(c.y)};
                        v[j] = xv + g4 * (ya * w0 + yc * w1); ss += (v[j][0] * v[j][0] + v[j][1] * v[j][1]) + (v[j][2] * v[j][2] + v[j][3] * v[j][3]); }
                    const float rstd = 1.f / sqrtf(wave_sum(ss) * (1.f / DM) + NORM_EPS);
                    f32x4* op = (f32x4*)(ap->out + (size_t)tok * DM);
#pragma unroll
                    for (int j = 0; j < 8; ++j) __builtin_nontemporal_store(v[j] * rstd * ((const f32x4*)gf)[64 * j + lane], op + 64 * j + lane);
                }
            }
        }
        }
}

__global__ void __launch_bounds__(512, 2) fwd(Args args) {
    extern __shared__ __attribute__((aligned(16))) unsigned char lds_raw[];
    LAS unsigned char* lds = (LAS unsigned char*)lds_raw;
    volatile LAS unsigned* MISC = (volatile LAS unsigned*)(lds + MISC_OFF);
    const int tid = threadIdx.x, lane = tid & 63, wave = __builtin_amdgcn_readfirstlane(tid >> 6);
    const int G = gridDim.x, bx = blockIdx.x;
    const int vcu = (G % 8 == 0) ? (bx % 8) * (G / 8) + bx / 8 : bx;
    const int gw = vcu * NWAVES + wave, NGW = G * NWAVES;
    unsigned char* ws = args.ws;
    const int lo = args.ph_lo, hi = args.ph_hi;
    for (int u = tid; u < (LDS_BYTES - MISC_OFF) / 4; u += 512) ((LAS unsigned*)(lds + MISC_OFF))[u] = 0u;
    __syncthreads();
    XcdBarrier bar; bar.bar = (unsigned*)(ws + WS_CTL); bar.x = 0; bar.st = nullptr;
    if (hi - lo > 1) bar = xcd_barrier_post((unsigned*)(ws + WS_CTL), MISC + 8);

    float* ADA = (float*)(ws + WS_ADA); float* ROPE = (float*)(ws + WS_ROPE); float* LAM = (float*)(ws + WS_LAM);

    REP(PH_P0) if (IN(PH_P0)) {
        LAS float* sv = (LAS float*)lds;
        LAS float* red = (LAS float*)(lds + 3 * 2048 * 4);
        for (int i = tid; i < 3 * DM; i += 512) { const int r = i / DM, k = i % DM; const float v = r < 2 ? args.in[I_C][r * DM + k] : args.in[I_CCTX][k]; sv[i] = fsilu(v); }
        __syncthreads();
        for (int it = vcu; it < 768; it += G) {
            const int l = it / 384, g = it % 384; const float* W = args.in[I_WADA] + (size_t)l * DM * ADA_N + 32 * g;
            const int kk = lane >> 5, col = lane & 31; float a0 = 0.f, a1 = 0.f, a2 = 0.f;
#pragma unroll 8
            for (int i = 0; i < 128; ++i) { const int k = 256 * wave + 2 * i + kk; const float w = __builtin_nontemporal_load(W + (size_t)k * ADA_N + col); a0 += sv[k] * w; a1 += sv[DM + k] * w; a2 += sv[2 * DM + k] * w; }
            a0 += __shfl_xor(a0, 32); a1 += __shfl_xor(a1, 32); a2 += __shfl_xor(a2, 32);
            if (lane < 32) { red[(wave * 3 + 0) * 32 + col] = a0; red[(wave * 3 + 1) * 32 + col] = a1; red[(wave * 3 + 2) * 32 + col] = a2; }
            __syncthreads();
            if (tid < 96) { const int r = tid / 32, c = tid % 32; float s = 0.f;
#pragma unroll
                for (int w = 0; w < 8; ++w) s += red[(w * 3 + r) * 32 + c];
                ADA[(size_t)(l * 3 + r) * ADA_N + 32 * g + c] = s + args.in[I_BADA][l * ADA_N + 32 * g + c]; }
            __syncthreads();
        }
        if (bx == 0) {
            for (int i = tid; i < 2048; i += 512) { const int pos = i >> 4, f = i & 15;
                const double inv = exp(-(double)f * (9.210340371976182736071965818737 / 16.0));
                const float invf = (float)inv; const float ang = (float)pos * invf;
                float c, s; sincos_d((double)ang, c, s); ROPE[i] = c; ROPE[2048 + i] = s; }
            if (wave == 0) {
                for (int l = 0; l < 2; ++l) {
                    const float p1 = wave_sum(args.in[I_LQ1][l * 64 + lane] * args.in[I_LK1][l * 64 + lane]);
                    const float p2 = wave_sum(args.in[I_LQ2][l * 64 + lane] * args.in[I_LK2][l * 64 + lane]);
                    const float lam_init = l == 0 ? 0.2f : (float)(0.8 - 0.6 * 0.74081822068171786607);
                    if (lane == 0) LAM[l] = expf(p1) - expf(p2) + lam_init;
                }
            }
        }
        __syncthreads();
        {
            CArgs ap0 = (CArgs)__builtin_amdgcn_kernarg_segment_ptr();
            unsigned* wq = (unsigned*)(ws + WS_CTL) + 8192;
            LAS int* nxt = (LAS int*)(lds + 8 * 16640 + 2048 + 256);
            for (;;) {
                if (tid == 0) nxt[0] = (int)atomicAdd(wq, 1u);
                __syncthreads();
                const int st = nxt[0];
                __syncthreads();
                if (st >= NSA) break;
                do_strip_A(ap0, st, lds, tid);
            }
        }
        SEAM(PH_P0);
    }

    run_layer<0>(lds, bar, lo, hi, G, bx, vcu);
    run_layer<1>(lds, bar, lo, hi, G, bx, vcu);
#undef IN
#undef SEAM
}

extern "C" void kernel_launch(void* const* d_in, const int* in_sizes, int n_in, void* d_out, int out_size, void* d_ws, size_t ws_size, hipStream_t stream) {
    static int grid = 0;
    if (grid == 0) {
        if (n_in != 28 || in_sizes[0] != NTOK * DM || out_size != NTOK * DM || ws_size < WS_END) {
            fprintf(stderr, "kernel_launch: shape/workspace mismatch: n_in %d in0 %d out %d ws %zu (need %zu); nothing launched\n", n_in, n_in > 0 ? in_sizes[0] : -1, out_size, ws_size, (size_t)WS_END);
            grid = -1; return; }
        int dev = 0, cus = 0, per_cu = 0;
        if (hipGetDevice(&dev) != hipSuccess || hipDeviceGetAttribute(&cus, hipDeviceAttributeMultiprocessorCount, dev) != hipSuccess) { grid = -1; return; }
        if (hipFuncSetAttribute((const void*)fwd, hipFuncAttributeMaxDynamicSharedMemorySize, LDS_BYTES) != hipSuccess) { fprintf(stderr, "kernel_launch: hipFuncSetAttribute failed\n"); grid = -1; return; }
        if (hipOccupancyMaxActiveBlocksPerMultiprocessor(&per_cu, (const void*)fwd, 512, LDS_BYTES) != hipSuccess || per_cu < 1)
            fprintf(stderr, "kernel_launch: occupancy query reports %d workgroups per CU\n", per_cu);
        (void)hipGetLastError();
        grid = cus;
    }
    if (grid < 0) return;
    (void)hipMemsetAsync((char*)d_ws + WS_CTL, 0, CTL_ZERO_BYTES, stream);
    Args a{};
    for (int i = 0; i < 28; ++i) a.in[i] = (const float*)d_in[i];
    a.out = (float*)d_out; a.ws = (unsigned char*)d_ws;
#if MK_MULTI
    for (int p = 0; p < PH_END; ++p) { if (!phase_valid(p)) continue; a.ph_lo = p; a.ph_hi = p + 1; hipLaunchKernelGGL(fwd, dim3(grid), dim3(512), LDS_BYTES, stream, a); }
#else
    a.ph_lo = 0; a.ph_hi = PH_END;
    hipLaunchKernelGGL(fwd, dim3(grid), dim3(512), LDS_BYTES, stream, a);
#endif
    const hipError_t le = hipPeekAtLastError();
    if (le != hipSuccess) fprintf(stderr, "kernel_launch: launch failed: %s\n", hipGetErrorName(le));
}
```

```cpp
#include <hip/hip_runtime.h>
#include <cstdio>
#include <cstdint>

#ifndef PROBE_DUP
#define PROBE_DUP (-1)
#endif
#ifndef PROBE_EPI2
#define PROBE_EPI2 0
#endif
#ifndef MK_MULTI
#define MK_MULTI 0
#endif

#define LAS __attribute__((address_space(3)))
#define GAS __attribute__((address_space(1)))
typedef unsigned short bf16_t;
typedef short bf16x8 __attribute__((ext_vector_type(8)));
typedef short s16x4 __attribute__((ext_vector_type(4)));
typedef float f32x2 __attribute__((ext_vector_type(2)));
typedef float f32x4 __attribute__((ext_vector_type(4)));
typedef float f32x16 __attribute__((ext_vector_type(16)));
typedef unsigned u32x2 __attribute__((ext_vector_type(2)));
typedef unsigned u32x4 __attribute__((ext_vector_type(4)));
typedef __bf16 bf16x2_t __attribute__((ext_vector_type(2)));
typedef int i32x4 __attribute__((ext_vector_type(4)));
typedef int i32x8 __attribute__((ext_vector_type(8)));

constexpr int DM = 2048, SEQ = 8192, CTXL = 256, NBATCH = 2, SEG = SEQ + CTXL, MALL = NBATCH * SEG, NTOK = NBATCH * SEQ;
constexpr int DIN = 4608, DFF = 5632, NEXP = 8;
constexpr int OFF_Q = 1024, OFF_CQ = 1792, OFF_KV = 2560, OFF_BV = 3328, OFF_CK = 4096, OFF_CV = 4352;
constexpr int MIX_DIFF = 512, MIX_SWA = 1280;
constexpr int UROWB = DIN * 2;
constexpr int Q8_OFF = 2048, QB_Q = 0, QB_CQ = 768, QB_K = 1536, QB_CK = 2304;
constexpr int ADA_N = 6 * DM;
constexpr int MOE_ROWS = NTOK * 2 + NEXP * 256;
constexpr int MOE_TILES_MAX = MOE_ROWS / 256;
constexpr float NORM_EPS = 1e-6f;

constexpr size_t MiB = 1u << 20;
constexpr size_t WS_CTL = 0, WS_RMX = 64 * 1024, CTL_ZERO_BYTES = 256 * 1024;
constexpr size_t WS_ADA = 1 * MiB;
constexpr size_t WS_ROPE = WS_ADA + 2 * 3 * ADA_N * 4;
constexpr size_t WS_LAM = WS_ROPE + 2 * 128 * 16 * 4;
constexpr size_t WS_CCNT = WS_LAM + 256;
constexpr size_t WS_TOKE = WS_CCNT + 256 * 8 * 4;
constexpr size_t WS_TOKW = WS_TOKE + NTOK * 4;
constexpr size_t WS_TOKP = WS_TOKW + NTOK * 8;
constexpr size_t WS_HSC = WS_TOKP + NTOK * 8;
constexpr size_t WS_HSS = WS_HSC + MALL * 4;
constexpr size_t WS_WSC1 = WS_HSS + MOE_ROWS * 4;
constexpr size_t WS_WSCX = WS_WSC1 + 2 * DFF * 4;
constexpr size_t WS_WSCIN = WS_WSCX + NEXP * 2 * DFF * 4;
constexpr size_t WS_WSCD = WS_WSCIN + 2 * DIN * 4;
constexpr size_t WS_HQS = WS_WSCD + 9 * DM * 4;
constexpr size_t WS_WSCO = WS_HQS + MOE_ROWS * 4;
constexpr size_t WS_MXS = WS_WSCO + 2 * DM * 4;
constexpr size_t WS_SMALL_END = WS_MXS + MALL * 4;
static_assert(WS_SMALL_END <= 4 * MiB && WS_RMX + MOE_ROWS * 4 <= CTL_ZERO_BYTES, "small tables");
constexpr size_t SZ_WIN = (size_t)DIN * DM * 2, SZ_WOUT = (size_t)DM * DM * 2, SZ_FF1 = (size_t)2 * DFF * DM * 2, SZ_FF2 = (size_t)DM * DFF * 2;
constexpr size_t WS_WIN = 4 * MiB;
constexpr size_t WS_WOUT = WS_WIN + 2 * SZ_WIN;
constexpr size_t WS_FF1 = WS_WOUT + 2 * SZ_WOUT;
constexpr size_t WS_FF2 = WS_FF1 + SZ_FF1;
constexpr size_t WS_EX1 = WS_FF2 + SZ_FF2;
constexpr size_t WS_EX2 = WS_EX1 + NEXP * SZ_FF1;
constexpr size_t WS_H = WS_EX2 + NEXP * SZ_FF2;
constexpr size_t WS_U = WS_H + (size_t)MALL * DM * 2;
constexpr size_t WS_OC = WS_U + (size_t)MALL * DIN * 2;
constexpr size_t WS_MIX = WS_OC + (size_t)2 * MALL * 768 * 4;
constexpr size_t WS_XL = WS_MIX + (size_t)MALL * DM * 2;
constexpr size_t WS_HMID = WS_XL + (size_t)MALL * DM * 4;
constexpr size_t WS_VT8 = WS_HMID + (size_t)MOE_ROWS * DFF;
constexpr size_t WS_END = WS_HMID + (size_t)MOE_ROWS * DFF * 2;
static_assert(WS_VT8 + (size_t)NBATCH * 1024 * SEG <= WS_END, "Vt8 fits");
constexpr size_t WS_HS = WS_U, WS_Y = WS_OC;
static_assert((size_t)MOE_ROWS * DM * 2 <= (size_t)MALL * DIN * 2, "HS fits in U");
static_assert((size_t)MOE_ROWS * DM * 2 <= WS_XL - WS_OC, "Y fits in OC+MIX");

constexpr int LDS_BYTES = 147456;
constexpr int MISC_OFF = 139264;
constexpr int NWAVES = 8;

__device__ __forceinline__ unsigned cvtpk(float lo, float hi) { f32x2 v = {lo, hi}; bf16x2_t b = __builtin_convertvector(v, bf16x2_t); return __builtin_bit_cast(unsigned, b); }
__device__ __forceinline__ float bf_lo(unsigned w) { return __uint_as_float(w << 16); }
__device__ __forceinline__ float bf_hi(unsigned w) { return __uint_as_float(w & 0xffff0000u); }
__device__ __forceinline__ f32x4 ldx4(const bf16_t* p) { const u32x2 w = *(const u32x2*)p; return (f32x4){bf_lo(w.x), bf_hi(w.x), bf_lo(w.y), bf_hi(w.y)}; }
__device__ __forceinline__ float wave_sum(float v) {
#pragma unroll
    for (int o = 1; o < 64; o <<= 1) v += __shfl_xor(v, o);
    return v;
}
__device__ __forceinline__ float fsilu(float x) { return x * __builtin_amdgcn_rcpf(1.f + __builtin_amdgcn_exp2f(-1.4426950408889634f * x)); }
__device__ __forceinline__ float fsigmoid(float x) { return __builtin_amdgcn_rcpf(1.f + __builtin_amdgcn_exp2f(-1.4426950408889634f * x)); }

namespace pg8 {
constexpr int BM = 256, BK = 64, HALF = 128, HTB = HALF * BK * 2, STAGE_BYTES = 8 * HTB, NXCD = 8, WGM = 4;
__host__ __device__ __forceinline__ int lds_byte(int r, int c) { const int st = (r >> 4) * 2 + (c >> 5), rr = r & 15, cc = c & 31, ob = rr * 64 + cc * 2; return st * 1024 + (ob ^ (((ob >> 9) & 1) << 5)); }
__host__ __device__ __forceinline__ void stage_rc(int b, int& R, int& C) { const int st = b / 1024, sb = b % 1024, swz = sb ^ (((sb >> 9) & 1) << 5); R = (st >> 1) * 16 + swz / 64; C = (st & 1) * 32 + (swz % 64) / 2; }
__host__ __device__ __forceinline__ int perm32(int rho) { const int n = rho >> 4, i = rho & 15; return 8 * (i >> 2) + 4 * n + (i & 3); }

struct Unit { int pm, pn, bn; };
struct Gemm { const bf16_t* A; const bf16_t* Bt; int K, ldA; };

struct TileSched {
    int nM, nN, nwg, G, c, mode; const LAS unsigned char* tile_e;
    __device__ __forceinline__ void init(int nM_, int nN_, int G_, int c_, int mode_, const LAS unsigned char* te) { nM = nM_; nN = nN_; nwg = nM * nN; G = G_; c = c_; mode = mode_; tile_e = te; }
    __device__ __forceinline__ bool next(int i, Unit& u) const {
        const long L = (long)i * G + c; if (L >= nwg) return false;
        int wgid = (int)L; { const int q = nwg / NXCD, r = nwg % NXCD, xcd = wgid % NXCD, off = wgid / NXCD; wgid = (xcd < r ? xcd * (q + 1) : r * (q + 1) + (xcd - r) * q) + off; }
        const int nig = WGM * nN, gid = wgid / nig, fm = gid * WGM, gsz = (nM - fm) < WGM ? (nM - fm) : WGM;
        const int im = fm + ((wgid % nig) % gsz); u.pn = (wgid % nig) / gsz;
        if (mode == 0) { u.pm = im; u.bn = u.pn; }
        else if (mode == 1) { u.pm = im + 1 + (im >= 32 ? 1 : 0); u.bn = u.pn; }
        else { u.pm = im; u.bn = (int)tile_e[im] * nN + u.pn; }
        return true;
    }
};


struct EpiIn {
    typedef f32x4 AccT;
    static constexpr bool PERM = false;
    bf16_t* U; const float* rope;
    __device__ __forceinline__ void operator()(const f32x4 (&acc)[2][2][4][2], const Unit& u, int wr, int wc, int fr, int fq) const {
        const bool rope_tile = (u.pn >= 4 && u.pn < 13) || u.pn == 16;
        const bool do_rope = rope_tile && (u.pm % 33) != 0;
        const int col0 = u.pn * BM + wc * 32 + 4 * fq;
#pragma unroll
        for (int ai = 0; ai < 2; ++ai)
#pragma unroll
            for (int m = 0; m < 4; ++m) {
                const int row = u.pm * BM + ai * HALF + wr * 64 + m * 16 + fr;
                f32x4 cv = {1.f, 1.f, 1.f, 1.f}, sv = {0.f, 0.f, 0.f, 0.f};
                if (do_rope) { const int t = (row % SEG) - CTXL; const int pos = (wc & 1) ? (t & 63) : (t >> 6);
                    cv = *(const f32x4*)(rope + pos * 16 + 4 * fq); sv = *(const f32x4*)(rope + 2048 + pos * 16 + 4 * fq); }
                bf16_t* rowp = U + (size_t)row * DIN + col0;
#pragma unroll
                for (int bj = 0; bj < 2; ++bj) {
                    const f32x4 v0 = acc[ai][bj][m][0], v1 = acc[ai][bj][m][1];
                    const f32x4 o0 = v0 * cv - v1 * sv, o1 = v1 * cv + v0 * sv;
                    u32x2 w0, w1; w0.x = cvtpk(o0[0], o0[1]); w0.y = cvtpk(o0[2], o0[3]); w1.x = cvtpk(o1[0], o1[1]); w1.y = cvtpk(o1[2], o1[3]);
                    *(u32x2*)(rowp + bj * HALF) = w0; *(u32x2*)(rowp + bj * HALF + 16) = w1; }
            }
    }
};
struct EpiInI8 {
    typedef i32x4 AccT;
    static constexpr bool PERM = false;
    static constexpr bool APERM = true;
    bf16_t* U; const float* rope; const float* sa; const float* sw; unsigned char* vt8;
    __device__ __forceinline__ void operator()(const i32x4 (&acc)[2][2][4][2], const Unit& u, int wr, int wc, int fr, int fq) const {
        const bool rope_tile = (u.pn >= 4 && u.pn < 13) || u.pn == 16;
        const bool do_rope = rope_tile && (u.pm % 33) != 0;
        const bool v_tile = (u.pn >= 13 && u.pn < 16) || u.pn == 17;
        const float qs = (u.pn >= 4 && u.pn < 10) ? 0.18033688011112042f : 1.f;
        const int col0 = u.pn * BM + wc * 32 + 4 * fq;
        f32x4 swv[2][2];
#pragma unroll
        for (int bj = 0; bj < 2; ++bj)
#pragma unroll
            for (int n = 0; n < 2; ++n) swv[bj][n] = *(const f32x4*)(sw + col0 + bj * HALF + n * 16);
        const int rowb = u.pm * BM + wr * 64 + 32 * ((fr >> 2) & 1) + 8 * (fr & 3) + 4 * (fr >> 3);
        if (v_tile) {
            const int b = u.pm / 33; const int key0 = u.pm * BM + wr * 64 - b * SEG;
            const int vcb = (u.pn == 17 ? 768 : (u.pn - 13) * 256) + wc * 32 + 4 * fq;
#pragma unroll
            for (int ai = 0; ai < 2; ++ai) {
                float a[4];
#pragma unroll
                for (int m = 0; m < 4; ++m) a[m] = sa[rowb + ai * HALF + m];
                unsigned char* d = vt8 + ((size_t)b * 1024 + vcb) * SEG + key0 + ai * HALF + 4 * fr;
#pragma unroll
                for (int bj = 0; bj < 2; ++bj)
#pragma unroll
                    for (int n = 0; n < 2; ++n)
#pragma unroll
                        for (int i = 0; i < 4; ++i) { float v[4];
#pragma unroll
                            for (int m = 0; m < 4; ++m) v[m] = __builtin_amdgcn_fmed3f((float)acc[ai][bj][m][n][i] * (a[m] * swv[bj][n][i]), -440.f, 440.f);
                            int w = 0; w = __builtin_amdgcn_cvt_pk_fp8_f32(v[0], v[1], w, false); w = __builtin_amdgcn_cvt_pk_fp8_f32(v[2], v[3], w, true);
                            *(unsigned*)(d + (size_t)(bj * HALF + 16 * n + i) * SEG) = (unsigned)w; }
            }
            return;
        }
        if (rope_tile) {
            const int qc = Q8_OFF + (u.pn == 16 ? QB_CK : (u.pn - 4) * BM) + wc * 32 + 8 * fq;
#pragma unroll
            for (int ai = 0; ai < 2; ++ai)
#pragma unroll
                for (int m = 0; m < 4; ++m) {
                    const int row = rowb + ai * HALF + m; const float a = sa[row] * qs;
                    f32x4 cv = {1.f, 1.f, 1.f, 1.f}, sv = {0.f, 0.f, 0.f, 0.f};
                    if (do_rope) { const int t = (row % SEG) - CTXL; const int pos = (wc & 1) ? (t & 63) : (t >> 6);
                        cv = *(const f32x4*)(rope + pos * 16 + 4 * fq); sv = *(const f32x4*)(rope + 2048 + pos * 16 + 4 * fq); }
                    unsigned char* rowp = (unsigned char*)U + (size_t)row * UROWB + qc;
#pragma unroll
                    for (int bj = 0; bj < 2; ++bj) {
                        const i32x4 i0 = acc[ai][bj][m][0], i1 = acc[ai][bj][m][1]; f32x4 v0, v1;
#pragma unroll
                        for (int i = 0; i < 4; ++i) { v0[i] = (float)i0[i] * (a * swv[bj][0][i]); v1[i] = (float)i1[i] * (a * swv[bj][1][i]); }
                        f32x4 o0 = v0 * cv - v1 * sv, o1 = v1 * cv + v0 * sv;
#pragma unroll
                        for (int i = 0; i < 4; ++i) { o0[i] = __builtin_amdgcn_fmed3f(o0[i], -440.f, 440.f); o1[i] = __builtin_amdgcn_fmed3f(o1[i], -440.f, 440.f); }
                        int w0 = 0, w1 = 0;
                        w0 = __builtin_amdgcn_cvt_pk_fp8_f32(o0[0], o0[1], w0, false); w0 = __builtin_amdgcn_cvt_pk_fp8_f32(o0[2], o0[3], w0, true);
                        w1 = __builtin_amdgcn_cvt_pk_fp8_f32(o1[0], o1[1], w1, false); w1 = __builtin_amdgcn_cvt_pk_fp8_f32(o1[2], o1[3], w1, true);
                        *(u32x2*)(rowp + bj * HALF) = (u32x2){(unsigned)w0, (unsigned)w1};
                    }
                }
            return;
        }
        const int colp = u.pn * BM + wc * 32 + 8 * fq;
#pragma unroll
        for (int ai = 0; ai < 2; ++ai)
#pragma unroll
            for (int m = 0; m < 4; ++m) {
                const int row = rowb + ai * HALF + m; const float a = sa[row];
                bf16_t* rowp = U + (size_t)row * DIN + colp;
#pragma unroll
                for (int bj = 0; bj < 2; ++bj) {
                    const i32x4 i0 = acc[ai][bj][m][0], i1 = acc[ai][bj][m][1]; f32x4 o0, o1;
#pragma unroll
                    for (int i = 0; i < 4; ++i) { o0[i] = (float)i0[i] * (a * swv[bj][0][i]); o1[i] = (float)i1[i] * (a * swv[bj][1][i]); }
                    u32x4 w; w.x = cvtpk(o0[0], o0[1]); w.y = cvtpk(o0[2], o0[3]); w.z = cvtpk(o1[0], o1[1]); w.w = cvtpk(o1[2], o1[3]);
                    *(u32x4*)(rowp + bj * HALF) = w;
                }
            }
    }
};
struct EpiRes {
    typedef f32x4 AccT;
    static constexpr bool PERM = false;
    const float* x; const float* ctx; const float* xl; int from_inputs; float* out; const float* ada; int goff;
    __device__ __forceinline__ void operator()(const f32x4 (&acc)[2][2][4][2], const Unit& u, int wr, int wc, int fr, int fq) const {
        const int b = u.pm / 33, j = u.pm % 33;
        const float* base = from_inputs ? (j == 0 ? ctx + (size_t)b * CTXL * DM : x + ((size_t)b * SEQ + (size_t)(j - 1) * BM) * DM) : xl + (size_t)u.pm * BM * DM;
        float* outp = out + (size_t)u.pm * BM * DM;
        const float* gate = ada + (j == 0 ? 2 : b) * ADA_N + goff;
        const int col0 = u.pn * BM + wc * 32 + 4 * fq;
        f32x4 gv[2][2];
#pragma unroll
        for (int bj = 0; bj < 2; ++bj)
#pragma unroll
            for (int n = 0; n < 2; ++n) gv[bj][n] = *(const f32x4*)(gate + col0 + bj * HALF + n * 16);
#pragma unroll
        for (int ai = 0; ai < 2; ++ai)
#pragma unroll
            for (int mp = 0; mp < 2; ++mp) {
                f32x4 bs[2][2][2];
#pragma unroll
                for (int mm = 0; mm < 2; ++mm) { const size_t off = (size_t)(ai * HALF + wr * 64 + (2 * mp + mm) * 16 + fr) * DM + col0;
#pragma unroll
                    for (int bj = 0; bj < 2; ++bj)
#pragma unroll
                        for (int n = 0; n < 2; ++n) bs[mm][bj][n] = *(const f32x4*)(base + off + bj * HALF + n * 16); }
#pragma unroll
                for (int mm = 0; mm < 2; ++mm) { const size_t off = (size_t)(ai * HALF + wr * 64 + (2 * mp + mm) * 16 + fr) * DM + col0;
#pragma unroll
                    for (int bj = 0; bj < 2; ++bj)
#pragma unroll
                        for (int n = 0; n < 2; ++n) *(f32x4*)(outp + off + bj * HALF + n * 16) = bs[mm][bj][n] + gv[bj][n] * acc[ai][bj][2 * mp + mm][n]; }
            }
    }
};
struct EpiGlu {
    typedef f32x4 AccT;
    static constexpr bool PERM = true;
    bf16_t* O;
    __device__ __forceinline__ void operator()(const f32x4 (&acc)[2][2][4][2], const Unit& u, int wr, int wc, int fr, int fq) const {
        const int col0 = u.pn * HALF + wc * 32 + 8 * fq;
#pragma unroll
        for (int ai = 0; ai < 2; ++ai)
#pragma unroll
            for (int m = 0; m < 4; ++m) { bf16_t* rowp = O + (size_t)(u.pm * BM + ai * HALF + wr * 64 + m * 16 + fr) * DFF + col0;
                const f32x4 g0 = acc[ai][0][m][0], g1 = acc[ai][0][m][1], u0 = acc[ai][1][m][0], u1 = acc[ai][1][m][1];
                u32x4 w; w.x = cvtpk(fsilu(g0[0]) * u0[0], fsilu(g0[1]) * u0[1]); w.y = cvtpk(fsilu(g0[2]) * u0[2], fsilu(g0[3]) * u0[3]);
                w.z = cvtpk(fsilu(g1[0]) * u1[0], fsilu(g1[1]) * u1[1]); w.w = cvtpk(fsilu(g1[2]) * u1[2], fsilu(g1[3]) * u1[3]);
                *(u32x4*)rowp = w; }
    }
};
struct EpiGluI8 {
    typedef i32x4 AccT;
    static constexpr bool PERM = true;
    unsigned char* O; const float* sa; const float* sw;
    __device__ __forceinline__ void operator()(const i32x4 (&acc)[2][2][4][2], const Unit& u, int wr, int wc, int fr, int fq) const {
        const int col0 = u.pn * HALF + wc * 32 + 8 * fq;
        const float* swp = sw + (size_t)u.bn * BM + wc * 32 + 8 * fq;
        const f32x4 sg0 = *(const f32x4*)(swp), sg1 = *(const f32x4*)(swp + 4), su0 = *(const f32x4*)(swp + HALF), su1 = *(const f32x4*)(swp + HALF + 4);
#pragma unroll
        for (int ai = 0; ai < 2; ++ai)
#pragma unroll
            for (int m = 0; m < 4; ++m) { const int row = u.pm * BM + ai * HALF + wr * 64 + m * 16 + fr; unsigned char* rowp = O + (size_t)row * DFF + col0; const float a = sa[row];
                const i32x4 ig0 = acc[ai][0][m][0], ig1 = acc[ai][0][m][1], iu0 = acc[ai][1][m][0], iu1 = acc[ai][1][m][1];
                f32x4 h0, h1;
#pragma unroll
                for (int i = 0; i < 4; ++i) { const float g0 = (float)ig0[i] * (a * sg0[i]), g1 = (float)ig1[i] * (a * sg1[i]), u0 = (float)iu0[i] * (a * su0[i]), u1 = (float)iu1[i] * (a * su1[i]);
                    h0[i] = __builtin_amdgcn_fmed3f(g0 * __builtin_amdgcn_rcpf(1.f + __builtin_amdgcn_exp2f(-g0)) * u0, -440.f, 440.f);
                    h1[i] = __builtin_amdgcn_fmed3f(g1 * __builtin_amdgcn_rcpf(1.f + __builtin_amdgcn_exp2f(-g1)) * u1, -440.f, 440.f); }
                unsigned w0 = 0u, w1 = 0u;
                w0 = __builtin_amdgcn_cvt_pk_fp8_f32(h0[0], h0[1], w0, false); w0 = __builtin_amdgcn_cvt_pk_fp8_f32(h0[2], h0[3], w0, true);
                w1 = __builtin_amdgcn_cvt_pk_fp8_f32(h1[0], h1[1], w1, false); w1 = __builtin_amdgcn_cvt_pk_fp8_f32(h1[2], h1[3], w1, true);
                *(u32x2*)rowp = (u32x2){w0, w1}; }
    }
};
struct EpiResI8 {
    typedef i32x4 AccT;
    static constexpr bool PERM = true;
    bf16_t* xl; const float* ada; int goff; const float* sa; const float* sw; const float* x; const float* ctx; int from_inputs;
    __device__ __forceinline__ void operator()(const i32x4 (&acc)[2][2][4][2], const Unit& u, int wr, int wc, int fr, int fq) const {
        const int b = u.pm / 33, j = u.pm % 33;
        bf16_t* outp = xl + (size_t)u.pm * BM * DM;
        const float* basef = j == 0 ? ctx + (size_t)b * CTXL * DM : x + ((size_t)b * SEQ + (size_t)(j - 1) * BM) * DM;
        const float* gate = ada + (j == 0 ? 2 : b) * ADA_N + goff;
        const int col0 = u.pn * BM + wc * 32 + 8 * fq;
        f32x4 gv[2][2];
#pragma unroll
        for (int bj = 0; bj < 2; ++bj)
#pragma unroll
            for (int n = 0; n < 2; ++n) gv[bj][n] = *(const f32x4*)(gate + col0 + bj * HALF + n * 4) * *(const f32x4*)(sw + col0 + bj * HALF + n * 4);
#pragma unroll
        for (int ai = 0; ai < 2; ++ai)
#pragma unroll
            for (int mp = 0; mp < 2; ++mp) {
                f32x4 bs[2][2][2]; float a[2];
#pragma unroll
                for (int mm = 0; mm < 2; ++mm) { const int r = ai * HALF + wr * 64 + (2 * mp + mm) * 16 + fr; const size_t off = (size_t)r * DM + col0; a[mm] = sa[u.pm * BM + r];
#pragma unroll
                    for (int bj = 0; bj < 2; ++bj) {
                        if (from_inputs) { bs[mm][bj][0] = *(const f32x4*)(basef + off + bj * HALF); bs[mm][bj][1] = *(const f32x4*)(basef + off + bj * HALF + 4); }
                        else { const u32x4 w = *(const u32x4*)(outp + off + bj * HALF); bs[mm][bj][0] = (f32x4){bf_lo(w.x), bf_hi(w.x), bf_lo(w.y), bf_hi(w.y)}; bs[mm][bj][1] = (f32x4){bf_lo(w.z), bf_hi(w.z), bf_lo(w.w), bf_hi(w.w)}; } } }
#pragma unroll
                for (int mm = 0; mm < 2; ++mm) { const size_t off = (size_t)(ai * HALF + wr * 64 + (2 * mp + mm) * 16 + fr) * DM + col0;
#pragma unroll
                    for (int bj = 0; bj < 2; ++bj) { f32x4 rr[2];
#pragma unroll
                        for (int n = 0; n < 2; ++n) { const i32x4 iv = acc[ai][bj][2 * mp + mm][n]; f32x4 fv;
#pragma unroll
                            for (int i = 0; i < 4; ++i) fv[i] = (float)iv[i] * a[mm];
                            rr[n] = bs[mm][bj][n] + gv[bj][n] * fv; }
                        u32x4 w; w.x = cvtpk(rr[0][0], rr[0][1]); w.y = cvtpk(rr[0][2], rr[0][3]); w.z = cvtpk(rr[1][0], rr[1][1]); w.w = cvtpk(rr[1][2], rr[1][3]);
                        *(u32x4*)(outp + off + bj * HALF) = w; } }
            }
    }
};
struct EpiBf16I8 {
    typedef i32x4 AccT;
    static constexpr bool PERM = true;
    bf16_t* O; const float* sa; const float* sw;
    __device__ __forceinline__ void operator()(const i32x4 (&acc)[2][2][4][2], const Unit& u, int wr, int wc, int fr, int fq) const {
        const int col0 = u.pn * BM + wc * 32 + 8 * fq;
        const float* swp = sw + (size_t)u.bn * BM + wc * 32 + 8 * fq;
        f32x4 s0[2], s1[2];
#pragma unroll
        for (int bj = 0; bj < 2; ++bj) { s0[bj] = *(const f32x4*)(swp + bj * HALF); s1[bj] = *(const f32x4*)(swp + bj * HALF + 4); }
#pragma unroll
        for (int ai = 0; ai < 2; ++ai)
#pragma unroll
            for (int m = 0; m < 4; ++m) { const int row = u.pm * BM + ai * HALF + wr * 64 + m * 16 + fr; bf16_t* rowp = O + (size_t)row * DM + col0; const float a = sa[row];
#pragma unroll
                for (int bj = 0; bj < 2; ++bj) { const i32x4 i0 = acc[ai][bj][m][0], i1 = acc[ai][bj][m][1]; f32x4 v0, v1;
#pragma unroll
                    for (int i = 0; i < 4; ++i) { v0[i] = (float)i0[i] * (a * s0[bj][i]); v1[i] = (float)i1[i] * (a * s1[bj][i]); }
                    u32x4 w; w.x = cvtpk(v0[0], v0[1]); w.y = cvtpk(v0[2], v0[3]); w.z = cvtpk(v1[0], v1[1]); w.w = cvtpk(v1[2], v1[3]);
                    *(u32x4*)(rowp + bj * HALF) = w; } }
    }
};
struct EpiResF8 {
    typedef f32x4 AccT;
    static constexpr bool PERM = true;
    bf16_t* xl; const float* ada; int goff; const float* sw;
    __device__ __forceinline__ void operator()(const f32x4 (&acc)[2][2][4][2], const Unit& u, int wr, int wc, int fr, int fq) const {
        const int b = u.pm / 33, j = u.pm % 33;
        bf16_t* outp = xl + (size_t)u.pm * BM * DM;
        const float* gate = ada + (j == 0 ? 2 : b) * ADA_N + goff;
        const int col0 = u.pn * BM + wc * 32 + 8 * fq;
        f32x4 gv[2][2];
#pragma unroll
        for (int bj = 0; bj < 2; ++bj)
#pragma unroll
            for (int n = 0; n < 2; ++n) gv[bj][n] = *(const f32x4*)(gate + col0 + bj * HALF + n * 4) * *(const f32x4*)(sw + col0 + bj * HALF + n * 4) * 0.25f;
#pragma unroll
        for (int ai = 0; ai < 2; ++ai)
#pragma unroll
            for (int mp = 0; mp < 2; ++mp) {
                u32x4 bs[2][2];
#pragma unroll
                for (int mm = 0; mm < 2; ++mm) { const size_t off = (size_t)(ai * HALF + wr * 64 + (2 * mp + mm) * 16 + fr) * DM + col0;
#pragma unroll
                    for (int bj = 0; bj < 2; ++bj) bs[mm][bj] = *(const u32x4*)(outp + off + bj * HALF); }
#pragma unroll
                for (int mm = 0; mm < 2; ++mm) { const size_t off = (size_t)(ai * HALF + wr * 64 + (2 * mp + mm) * 16 + fr) * DM + col0;
#pragma unroll
                    for (int bj = 0; bj < 2; ++bj) { const u32x4 w0 = bs[mm][bj];
                        const f32x4 b0 = {bf_lo(w0.x), bf_hi(w0.x), bf_lo(w0.y), bf_hi(w0.y)}, b1 = {bf_lo(w0.z), bf_hi(w0.z), bf_lo(w0.w), bf_hi(w0.w)};
                        const f32x4 r0 = b0 + gv[bj][0] * acc[ai][bj][2 * mp + mm][0], r1 = b1 + gv[bj][1] * acc[ai][bj][2 * mp + mm][1];
                        u32x4 w; w.x = cvtpk(r0[0], r0[1]); w.y = cvtpk(r0[2], r0[3]); w.z = cvtpk(r1[0], r1[1]); w.w = cvtpk(r1[2], r1[3]);
                        *(u32x4*)(outp + off + bj * HALF) = w; } }
            }
    }
};
struct EpiBf16F8 {
    typedef f32x4 AccT;
    static constexpr bool PERM = true;
    bf16_t* O; const float* sw;
    __device__ __forceinline__ void operator()(const f32x4 (&acc)[2][2][4][2], const Unit& u, int wr, int wc, int fr, int fq) const {
        const int col0 = u.pn * BM + wc * 32 + 8 * fq;
        const float* swp = sw + (size_t)u.bn * BM + wc * 32 + 8 * fq;
        f32x4 s0[2], s1[2];
#pragma unroll
        for (int bj = 0; bj < 2; ++bj) { s0[bj] = *(const f32x4*)(swp + bj * HALF) * 0.25f; s1[bj] = *(const f32x4*)(swp + bj * HALF + 4) * 0.25f; }
#pragma unroll
        for (int ai = 0; ai < 2; ++ai)
#pragma unroll
            for (int m = 0; m < 4; ++m) { bf16_t* rowp = O + (size_t)(u.pm * BM + ai * HALF + wr * 64 + m * 16 + fr) * DM + col0;
#pragma unroll
                for (int bj = 0; bj < 2; ++bj) { const f32x4 v0 = acc[ai][bj][m][0] * s0[bj], v1 = acc[ai][bj][m][1] * s1[bj];
                    u32x4 w; w.x = cvtpk(v0[0], v0[1]); w.y = cvtpk(v0[2], v0[3]); w.z = cvtpk(v1[0], v1[1]); w.w = cvtpk(v1[2], v1[3]);
                    *(u32x4*)(rowp + bj * HALF) = w; } }
    }
};
struct EpiBf16 {
    typedef f32x4 AccT;
    static constexpr bool PERM = true;
    bf16_t* O;
    __device__ __forceinline__ void operator()(const f32x4 (&acc)[2][2][4][2], const Unit& u, int wr, int wc, int fr, int fq) const {
        const int col0 = u.pn * BM + wc * 32 + 8 * fq;
#pragma unroll
        for (int ai = 0; ai < 2; ++ai)
#pragma unroll
            for (int m = 0; m < 4; ++m) { bf16_t* rowp = O + (size_t)(u.pm * BM + ai * HALF + wr * 64 + m * 16 + fr) * DM + col0;
#pragma unroll
                for (int bj = 0; bj < 2; ++bj) { const f32x4 v0 = acc[ai][bj][m][0], v1 = acc[ai][bj][m][1];
                    u32x4 w; w.x = cvtpk(v0[0], v0[1]); w.y = cvtpk(v0[2], v0[3]); w.z = cvtpk(v1[0], v1[1]); w.w = cvtpk(v1[2], v1[3]);
                    *(u32x4*)(rowp + bj * HALF) = w; } }
    }
};

template <class T> struct EpiAPerm { static constexpr bool v = false; };
template <> struct EpiAPerm<EpiInI8> { static constexpr bool v = true; };
template <class T> struct EpiCode { static constexpr int v = 0; };
template <> struct EpiCode<EpiInI8> { static constexpr int v = 1; };
template <> struct EpiCode<EpiGluI8> { static constexpr int v = 2; };
template <> struct EpiCode<EpiBf16F8> { static constexpr int v = 3; };
template <class Epi, bool ALIGN_EPI, int MODE = 0>
__device__ __forceinline__ void gemm_phase(LAS unsigned char* lds, const Gemm g, const TileSched& S, const Epi& E) {
    int tid = threadIdx.x; asm volatile("" : "+v"(tid));
    const int wid = __builtin_amdgcn_readfirstlane(tid >> 6), lane = tid & 63, wr = wid >> 2, wc = wid & 3, fr = lane & 15, fq = lane >> 4;
    const int K = g.K, nt = K / BK;
    unsigned voffA[2], voffB[2];
#pragma unroll
    for (int i = 0; i < 2; ++i) { int R, C; stage_rc((wid * 2 + i) * 1024 + lane * 16, R, C); const int Rb = Epi::PERM ? ((R & ~31) + perm32(R & 31)) : R;
        const int Ra = EpiAPerm<Epi>::v ? ((R & ~63) + 32 * ((R >> 2) & 1) + 8 * (R & 3) + 4 * ((R >> 3) & 1) + ((R >> 4) & 3)) : R;
        voffA[i] = (unsigned)(Ra * g.ldA + C) * 2u + (i == 0 ? 1024u : 0u); voffB[i] = (unsigned)(Rb * K + C) * 2u + (i == 0 ? 1024u : 0u); }
    const size_t kstep = (size_t)(BK * 2);
    const size_t hstep = (size_t)HALF * K * 2, hstepA = (size_t)HALF * g.ldA * 2;
    const size_t tstep = 2 * hstep, tstepA = 2 * hstepA;
    const unsigned ldsw = (unsigned)wid * 2048u + 1024u, ldsb = (unsigned)(uintptr_t)lds;
    const int aoff = lds_byte(wr * 64 + fr, fq * 8), boff = lds_byte(wc * 32 + fr, fq * 8);
#define PG8_SA(b, h) (((b) * 2 + (h)) * HTB)
#define PG8_SB(b, h) ((4 + (b) * 2 + (h)) * HTB)
#define PG8_STAGE(bufoff, gbase, voff) do {   \
        asm volatile("s_mov_b32 m0, %3\n\ts_nop 0\n\tglobal_load_lds_dwordx4 %0, %2 offset:-1024\n\tglobal_load_lds_dwordx4 %1, %2" :: "v"((voff)[0]), "v"((voff)[1]), "s"((const char*)(gbase)), "s"(ldsb + (unsigned)(bufoff) + ldsw) : "memory", "m0"); } while (0)
#define PG8_LDA(dst, b, h) do { _Pragma("unroll") for (int m = 0; m < 4; ++m) { const i32x4 lo_ = *(const LAS i32x4*)(lds + PG8_SA(b, h) + aoff + m * 2048), hi_ = *(const LAS i32x4*)(lds + PG8_SA(b, h) + aoff + m * 2048 + 1024); \
        dst[m] = __builtin_shufflevector(lo_, hi_, 0, 1, 2, 3, 4, 5, 6, 7); } } while (0)
#define PG8_LDB(dst, b, h) do { _Pragma("unroll") for (int n = 0; n < 2; ++n) { const i32x4 lo_ = *(const LAS i32x4*)(lds + PG8_SB(b, h) + boff + n * 2048), hi_ = *(const LAS i32x4*)(lds + PG8_SB(b, h) + boff + n * 2048 + 1024); \
        dst[n] = __builtin_shufflevector(lo_, hi_, 0, 1, 2, 3, 4, 5, 6, 7); } } while (0)
#define PG8_MMA(ai, bj, At, Bt) do { __builtin_amdgcn_s_setprio(1); _Pragma("unroll") for (int m = 0; m < 4; ++m) _Pragma("unroll") for (int n = 0; n < 2; ++n) { \
        if constexpr (MODE == 2) {   \
            acc[ai][bj][m][n] = __builtin_amdgcn_mfma_scale_f32_16x16x128_f8f6f4(Bt[n], At[m], acc[ai][bj][m][n], 0, 0, 0, 0, 0, 0); \
        } else if constexpr (MODE == 1) { \
            acc[ai][bj][m][n] = __builtin_amdgcn_mfma_i32_16x16x64_i8(Bt[n].lo, At[m].lo, acc[ai][bj][m][n], 0, 0, 0); acc[ai][bj][m][n] = __builtin_amdgcn_mfma_i32_16x16x64_i8(Bt[n].hi, At[m].hi, acc[ai][bj][m][n], 0, 0, 0); \
        } else { \
            acc[ai][bj][m][n] = __builtin_amdgcn_mfma_f32_16x16x32_bf16(__builtin_bit_cast(bf16x8, Bt[n].lo), __builtin_bit_cast(bf16x8, At[m].lo), acc[ai][bj][m][n], 0, 0, 0); \
            acc[ai][bj][m][n] = __builtin_amdgcn_mfma_f32_16x16x32_bf16(__builtin_bit_cast(bf16x8, Bt[n].hi), __builtin_bit_cast(bf16x8, At[m].hi), acc[ai][bj][m][n], 0, 0, 0); } } __builtin_amdgcn_s_setprio(0); } while (0)
#define PG8_WAIT_V(n) asm volatile("s_waitcnt vmcnt(" #n ")" ::: "memory")
#define PG8_WAIT_L(n) asm volatile("s_waitcnt lgkmcnt(" #n ")" ::: "memory")
#define PG8_BAR __builtin_amdgcn_s_barrier()
#define PG8_SCHED __builtin_amdgcn_sched_barrier(0)
    Unit cur, nxt; int ui = 0;
    if (!S.next(0, cur)) return;
    typedef typename Epi::AccT AccT;
    AccT acc[2][2][4][2];
#pragma unroll
    for (int a = 0; a < 2; ++a)
#pragma unroll
        for (int b = 0; b < 2; ++b)
#pragma unroll
            for (int m = 0; m < 4; ++m)
#pragma unroll
                for (int n = 0; n < 2; ++n) acc[a][b][m][n] = (AccT){0, 0, 0, 0};
    i32x8 At[4], B0[2], B1[2];
    const char* cA = (const char*)g.A + (size_t)cur.pm * tstepA; const char* cB = (const char*)g.Bt + (size_t)cur.bn * tstep;
    PG8_STAGE(PG8_SB(0, 0), cB, voffB); PG8_STAGE(PG8_SB(0, 1), cB + hstep, voffB); PG8_STAGE(PG8_SA(0, 0), cA, voffA); PG8_STAGE(PG8_SA(0, 1), cA + hstepA, voffA);
    if (wr == 1) PG8_BAR;
    PG8_WAIT_V(2); PG8_BAR;
    PG8_STAGE(PG8_SB(1, 0), cB + kstep, voffB); PG8_STAGE(PG8_SA(1, 0), cA + kstep, voffA); PG8_STAGE(PG8_SB(1, 1), cB + hstep + kstep, voffB);
    PG8_WAIT_V(6); PG8_BAR;
    for (;;) {
        const bool has_next = S.next(ui + 1, nxt);
        const char* nA = has_next ? (const char*)g.A + (size_t)nxt.pm * tstepA : cA; const char* nB = has_next ? (const char*)g.Bt + (size_t)nxt.bn * tstep : cB;
        for (int t = 0; t < nt; t += 2) {
            const bool last = (t == nt - 2);
            const char* a1 = cA + (size_t)(t + 1) * kstep;
            const char* a2 = last ? nA : cA + (size_t)(t + 2) * kstep; const char* b2 = last ? nB : cB + (size_t)(t + 2) * kstep;
            const char* a3 = a2 + kstep; const char* b3 = b2 + kstep;
            PG8_LDB(B0, 0, 0); PG8_LDB(B1, 0, 1); PG8_SCHED; PG8_LDA(At, 0, 0); PG8_STAGE(PG8_SA(1, 1), a1 + hstepA, voffA);
            PG8_WAIT_V(8); PG8_WAIT_L(0); PG8_BAR; PG8_MMA(0, 0, At, B0); PG8_MMA(0, 1, At, B1); PG8_BAR; PG8_SCHED;
            PG8_LDA(At, 0, 1); PG8_STAGE(PG8_SB(0, 0), b2, voffB); PG8_STAGE(PG8_SB(0, 1), b2 + hstep, voffB); PG8_STAGE(PG8_SA(0, 0), a2, voffA);
            PG8_WAIT_V(8); PG8_WAIT_L(0); PG8_BAR; PG8_MMA(1, 0, At, B0); PG8_MMA(1, 1, At, B1); PG8_BAR; PG8_SCHED;
            PG8_LDB(B0, 1, 0); PG8_LDB(B1, 1, 1); PG8_SCHED; PG8_LDA(At, 1, 0); PG8_STAGE(PG8_SA(0, 1), a2 + hstepA, voffA);
            PG8_WAIT_V(8); PG8_WAIT_L(0); PG8_BAR; PG8_MMA(0, 0, At, B0); PG8_MMA(0, 1, At, B1); PG8_BAR; PG8_SCHED;
            PG8_LDA(At, 1, 1); PG8_STAGE(PG8_SB(1, 0), b3, voffB); PG8_STAGE(PG8_SB(1, 1), b3 + hstep, voffB); PG8_STAGE(PG8_SA(1, 0), a3, voffA);
            PG8_WAIT_V(8); PG8_WAIT_L(0); PG8_BAR; PG8_MMA(1, 0, At, B0); PG8_MMA(1, 1, At, B1); PG8_BAR; PG8_SCHED;
        }
        if constexpr (ALIGN_EPI) { if (wr == 0) PG8_BAR; }
        { int fr_ = fr, fq_ = fq; asm volatile("" : "+v"(fr_), "+v"(fq_));
          E(acc, cur, wr, wc, fr_, fq_);
          if constexpr (PROBE_EPI2 != 0 && EpiCode<Epi>::v == PROBE_EPI2) { asm volatile("" : "+v"(fr_), "+v"(fq_) :: "memory"); E(acc, cur, wr, wc, fr_, fq_); } }
        if (!has_next) break;
#pragma unroll
        for (int a = 0; a < 2; ++a)
#pragma unroll
            for (int b = 0; b < 2; ++b)
#pragma unroll
                for (int m = 0; m < 4; ++m)
#pragma unroll
                    for (int n = 0; n < 2; ++n) acc[a][b][m][n] = (AccT){0, 0, 0, 0};
        cur = nxt; cA = nA; cB = nB; ++ui;
        if constexpr (ALIGN_EPI) { if (wr == 1) PG8_BAR; }
    }
    PG8_WAIT_V(0);
    if constexpr (!ALIGN_EPI) { if (wr == 0) PG8_BAR; }
    PG8_BAR;
#undef PG8_SA
#undef PG8_SB
#undef PG8_STAGE
#undef PG8_LDA
#undef PG8_LDB
#undef PG8_MMA
#undef PG8_WAIT_V
#undef PG8_WAIT_L
#undef PG8_BAR
#undef PG8_SCHED
}
}

namespace att {
constexpr float SCALE = 0.125f;
constexpr float THR = 8.f;
constexpr int V_BYTES = 8192, K_BYTES = 4096;
constexpr int LDS_V = 0, LDS_K = 3 * V_BYTES, LDS_WS = LDS_K + 3 * K_BYTES, LDS_TOTAL = LDS_WS + NWAVES * 64 * 4;
#define SBAR() __builtin_amdgcn_sched_barrier(0)
__device__ __forceinline__ int crow(int r, int hi) { return (r & 3) + 8 * (r >> 2) + 4 * hi; }
constexpr float THR2 = 8.f;
template <bool FIRST>
__device__ __forceinline__ void partialSM(f32x16& p0, f32x16& p1, float& mref, f32x16& negm, float& alpha) {
    float pa_ = fmaxf(fmaxf(p0[0], p0[1]), p1[0]), pb_ = fmaxf(fmaxf(p0[2], p0[3]), p1[1]); pa_ = fmaxf(fmaxf(pa_, p1[2]), p1[3]);
#pragma unroll
    for (int r = 4; r < 16; r += 4) { pa_ = fmaxf(fmaxf(pa_, p0[r]), p0[r + 1]); pb_ = fmaxf(fmaxf(pb_, p0[r + 2]), p0[r + 3]); pa_ = fmaxf(fmaxf(pa_, p1[r]), p1[r + 1]); pb_ = fmaxf(fmaxf(pb_, p1[r + 2]), p1[r + 3]); }
    float pmax = fmaxf(pa_, pb_);
    { auto rr = __builtin_amdgcn_permlane32_swap(__float_as_uint(pmax), __float_as_uint(pmax), false, false);
      pmax = fmaxf(__uint_as_float(rr[0]), __uint_as_float(rr[1])); }
    alpha = 1.f;
    if (FIRST || __builtin_expect(__any(pmax > THR2), 0)) {
        const float dl = FIRST ? pmax : fmaxf(pmax, 0.f);
        mref += dl; alpha = __builtin_amdgcn_exp2f(-dl);
#pragma unroll
        for (int r = 0; r < 16; ++r) { p0[r] -= dl; p1[r] -= dl; }
        const float nm = -mref;
#pragma unroll
        for (int r = 0; r < 16; ++r) negm[r] = nm;
        asm volatile("" : "+v"(negm));
    }
#pragma unroll
    for (int r = 0; r < 16; ++r) p0[r] = __builtin_amdgcn_exp2f(p0[r]);
}
__device__ __forceinline__ void finishSM(f32x16& p0, f32x16& p1, i32x8& P8) {
#pragma unroll
    for (int r = 0; r < 16; ++r) p1[r] = __builtin_amdgcn_exp2f(p1[r]);
#pragma unroll
    for (int w = 0; w < 4; ++w) { int x, y; asm volatile("" : "=v"(x), "=v"(y));
        x = __builtin_amdgcn_cvt_pk_fp8_f32(p0[4 * w], p0[4 * w + 1], x, false); x = __builtin_amdgcn_cvt_pk_fp8_f32(p0[4 * w + 2], p0[4 * w + 3], x, true); P8[w] = x;
        y = __builtin_amdgcn_cvt_pk_fp8_f32(p1[4 * w], p1[4 * w + 1], y, false); y = __builtin_amdgcn_cvt_pk_fp8_f32(p1[4 * w + 2], p1[4 * w + 3], y, true); P8[4 + w] = y; }
}
__device__ __forceinline__ void kload(i32x8 (&kf)[2], const LAS unsigned char* Ks, int vfa, int vfb) {
#pragma unroll
    for (int d0 = 0; d0 < 2; ++d0) { const i32x4 lo_ = *(const LAS i32x4*)(Ks + d0 * 2048 + vfa), hi_ = *(const LAS i32x4*)(Ks + d0 * 2048 + vfb); kf[d0] = __builtin_shufflevector(lo_, hi_, 0, 1, 2, 3, 4, 5, 6, 7); }
}
__device__ __forceinline__ void qk_mma(f32x16& p0, f32x16& p1, const i32x8 (&kf)[2], const i32x8& q8, const f32x16& negm) {
    p0 = __builtin_amdgcn_mfma_scale_f32_32x32x64_f8f6f4(kf[0], q8, negm, 0, 0, 0, 0, 0, 0);
    p1 = __builtin_amdgcn_mfma_scale_f32_32x32x64_f8f6f4(kf[1], q8, negm, 0, 0, 0, 0, 0, 0);
}
template <int DV> __device__ __forceinline__ void pv_all(f32x16* o, f32x16& lacc, const LAS unsigned char* Vs, int vfa, int vfb, const i32x8& P8, const i32x8& ones) {
    i32x8 V8[DV / 32];
#pragma unroll
    for (int d0 = 0; d0 < DV / 32; ++d0) { const i32x4 lo_ = *(const LAS i32x4*)(Vs + d0 * 2048 + vfa), hi_ = *(const LAS i32x4*)(Vs + d0 * 2048 + vfb); V8[d0] = __builtin_shufflevector(lo_, hi_, 0, 1, 2, 3, 4, 5, 6, 7); }
    lacc = __builtin_amdgcn_mfma_scale_f32_32x32x64_f8f6f4(P8, ones, lacc, 0, 0, 0, 0, 0, 0);
#pragma unroll
    for (int d0 = 0; d0 < DV / 32; ++d0) o[d0] = __builtin_amdgcn_mfma_scale_f32_32x32x64_f8f6f4(P8, V8[d0], o[d0], 0, 0, 0, 0, 0, 0);
}
__device__ __forceinline__ void wmask(f32x16& p0, f32x16& p1, int dt, int hi) {
    const int lo = dt - 128, hb = dt + 128;
#pragma unroll
    for (int r = 0; r < 16; ++r) { const int k0 = crow(r, hi), k1 = k0 + 32;
        if (k0 < lo || k0 > hb) p0[r] = -1e30f; if (k1 < lo || k1 > hb) p1[r] = -1e30f; }
}

__device__ __forceinline__ void glds16(const void* gsrc, unsigned lds_dst) {
    asm volatile("s_mov_b32 m0, %1\n\ts_nop 0\n\tglobal_load_lds_dwordx4 %0, off" :: "v"(gsrc), "s"(lds_dst) : "memory", "m0"); }
#define WAIT_BAR(N) asm volatile("s_waitcnt vmcnt(" #N ") lgkmcnt(0)\n\ts_barrier" ::: "memory")
template <int DV, bool SWA>
__device__ __forceinline__ void attn_unit(const unsigned char* __restrict__ Qb, const unsigned char* __restrict__ Kseg, const unsigned char* __restrict__ Vt, int NT, int loc0,
                                          bool masked, int dq0, float sinkv, bf16_t* Ob, int ldo, LAS unsigned char* lds) {
    int tid = threadIdx.x; asm volatile("" : "+v"(tid));
    const int lane = tid & 63, r32 = lane & 31, hi = lane >> 5; const int wid = __builtin_amdgcn_readfirstlane(tid >> 6);
    LAS unsigned char* V_lds = lds + LDS_V; LAS unsigned char* K_lds = lds + LDS_K;
    LAS float* wsf = (LAS float*)(lds + LDS_WS) + wid * 64; LAS float* al_l = wsf;
    float mref = SWA ? sinkv * 1.4426950408889634f : 0.f;
    f32x16 negm, lacc;
#pragma unroll
    for (int r = 0; r < 16; ++r) { negm[r] = -mref; lacc[r] = SWA ? 1.f : 0.f; }
    asm volatile("" : "+v"(negm));
    f32x16 o[DV / 32];
#pragma unroll
    for (int d = 0; d < DV / 32; ++d) o[d] = f32x16{};
    asm volatile("s_waitcnt vmcnt(0)" ::: "memory");
    i32x8 q8;
    { const unsigned char* Qw = Qb + (size_t)(wid * 32 + r32) * UROWB + hi * 32;
      const i32x4 lo_ = *(const i32x4*)Qw, hi_ = *(const i32x4*)(Qw + 16); q8 = __builtin_shufflevector(lo_, hi_, 0, 1, 2, 3, 4, 5, 6, 7); }
    const int kw = wid & 3, kg = kw * 64 + lane, kcol = kg >> 2, kch = (kg & 3) ^ ((kcol >> 2) & 3);
    const unsigned char* ksrc = Kseg + (size_t)kcol * UROWB + kch * 16;
    const int vw = DV == 128 ? wid : (wid & 3);
    const unsigned kdst = (unsigned)(uintptr_t)K_lds + kw * 1024, vdst = (unsigned)(uintptr_t)V_lds + vw * 1024;
    const int vg = vw * 64 + lane, vcol = vg >> 2, vch = (vg & 3) ^ ((vcol >> 2) & 3);
    const unsigned char* vsrc = Vt + (size_t)vcol * SEG + vch * 16;
    const int vx = (r32 >> 2) & 3, vfa = r32 * 64 + (((2 * hi) ^ vx) << 4), vfb = r32 * 64 + (((2 * hi + 1) ^ vx) << 4);
#define TROW(t) ((t) < 4 ? (t) * 64 : loc0 + ((t) - 4) * 64)
#define DMA_K(t, slot) glds16(ksrc + (size_t)TROW(t) * UROWB, (unsigned)__builtin_amdgcn_readfirstlane(kdst + (slot) * K_BYTES))
#define DMA_V(t, slot) glds16(vsrc + TROW(t), (unsigned)__builtin_amdgcn_readfirstlane(vdst + (slot) * V_BYTES))
#define RESC(a) do { if (__any((a) < 1.f)) { if (hi == 0) al_l[r32] = (a); asm volatile("s_waitcnt lgkmcnt(0)" ::: "memory"); \
        _Pragma("unroll") for (int r = 0; r < 16; ++r) { const float f_ = al_l[crow(r, hi)]; lacc[r] *= f_; _Pragma("unroll") for (int d = 0; d < DV / 32; ++d) o[d][r] *= f_; } } } while (0)
#define MASK(P0, P1, t) do { if (SWA && masked && (t) >= 4) wmask(P0, P1, dqw - ((t) - 4) * 64, hi); } while (0)
#define ROT() do { const int t_ = sp; sp = sc; sc = sn; sn = t_; } while (0)
    const int dqw = dq0 + wid * 32 + r32;
    f32x16 pA0, pA1, pB0, pB1; float alA, alB; i32x8 P8; i32x8 kf[2];
    i32x8 ones = {0x38383838, 0x38383838, 0x38383838, 0x38383838, 0x38383838, 0x38383838, 0x38383838, 0x38383838};
    asm volatile("" : "+v"(ones));
    int sp = 2, sc = 0, sn = 1;
    if (wid >= 4) __builtin_amdgcn_s_setprio(1);
    DMA_K(0, 0); DMA_V(0, 0); DMA_K(1, 1);
    WAIT_BAR(2);
    DMA_K(2, sp); DMA_V(1, sn);
    kload(kf, K_lds + sc * K_BYTES, vfa, vfb); qk_mma(pA0, pA1, kf, q8, negm); MASK(pA0, pA1, 0); partialSM<!SWA>(pA0, pA1, mref, negm, alA);
    if constexpr (SWA) RESC(alA);
    ROT();
    for (int j = 1; j < NT - 1; j += 2) {
        WAIT_BAR(2);
        SBAR(); kload(kf, K_lds + sc * K_BYTES, vfa, vfb); SBAR();
        DMA_K(j + 2, sp); DMA_V(j + 1, sn);
        SBAR(); qk_mma(pB0, pB1, kf, q8, negm);
        finishSM(pA0, pA1, P8); SBAR();
        pv_all<DV>(o, lacc, V_lds + sp * V_BYTES, vfa, vfb, P8, ones); MASK(pB0, pB1, j); partialSM<false>(pB0, pB1, mref, negm, alB);
        RESC(alB); ROT();
        WAIT_BAR(2);
        SBAR(); kload(kf, K_lds + sc * K_BYTES, vfa, vfb); SBAR();
        if (j + 3 < NT) DMA_K(j + 3, sp);
        DMA_V(j + 2, sn);
        SBAR(); qk_mma(pA0, pA1, kf, q8, negm);
        finishSM(pB0, pB1, P8); SBAR();
        pv_all<DV>(o, lacc, V_lds + sp * V_BYTES, vfa, vfb, P8, ones); MASK(pA0, pA1, j + 1); partialSM<false>(pA0, pA1, mref, negm, alA);
        RESC(alA); ROT();
    }
    WAIT_BAR(1);
    SBAR(); kload(kf, K_lds + sc * K_BYTES, vfa, vfb); qk_mma(pB0, pB1, kf, q8, negm);
    finishSM(pA0, pA1, P8); SBAR();
    pv_all<DV>(o, lacc, V_lds + sp * V_BYTES, vfa, vfb, P8, ones); MASK(pB0, pB1, NT - 1); partialSM<false>(pB0, pB1, mref, negm, alB);
    RESC(alB); ROT();
    WAIT_BAR(0);
    finishSM(pB0, pB1, P8); SBAR();
    pv_all<DV>(o, lacc, V_lds + sp * V_BYTES, vfa, vfb, P8, ones);
    float rli[16];
#pragma unroll
    for (int r = 0; r < 16; ++r) rli[r] = __builtin_amdgcn_rcpf(lacc[r]);
    {
        bf16_t* Ow = Ob + (size_t)(wid * 32) * ldo;
#pragma unroll
        for (int r = 0; r < 16; ++r) { const int orow = crow(r, hi);
#pragma unroll
            for (int d0 = 0; d0 < DV / 32; ++d0) Ow[(size_t)orow * ldo + d0 * 32 + r32] = (bf16_t)(cvtpk(o[d0][r] * rli[r], 0.f) & 0xffffu); }
    }
    __builtin_amdgcn_s_setprio(0);
    __syncthreads();
#undef TROW
#undef DMA_K
#undef DMA_V
#undef RESC
#undef MASK
#undef ROT
}
#undef WAIT_BAR
#undef SBAR
}

#define XB_TMO      128
#define XB_XCNT(j)  (256  + 64 * (j))
#define XB_XSUB(j)  (1280 + 64 * (j))
#define XB_XGEN(j)  (2304 + 64 * (j))
#define XB_TOP      3328
#define XB_TOPGEN   3392
#define XCD_BAR_WORDS 3456
#define XB_SPIN_CAP (1u << 18)
__device__ __forceinline__ unsigned xb_ld(unsigned* p)              { return __hip_atomic_load(p, __ATOMIC_RELAXED, __HIP_MEMORY_SCOPE_AGENT); }
__device__ __forceinline__ unsigned xb_add(unsigned* p, unsigned v) { return __hip_atomic_fetch_add(p, v, __ATOMIC_RELAXED, __HIP_MEMORY_SCOPE_AGENT); }
__device__ __forceinline__ unsigned xb_xcc_id() { return (unsigned)__builtin_amdgcn_s_getreg((3 << 11) | 20) & 0xFu; }
#define XB_SPIN(cond, bar) do { unsigned _sp = 0; while (cond) { __builtin_amdgcn_s_sleep(1); \
    if ((++_sp & 255u) == 0u) { if (xb_ld(&(bar)[XB_TMO])) break; if (_sp > XB_SPIN_CAP) { atomicAdd(&(bar)[XB_TMO], 1u); break; } } } } while (0)
struct XcdBarrier { unsigned* bar; unsigned x; volatile LAS unsigned* st; };
__device__ __forceinline__ XcdBarrier xcd_barrier_post(unsigned* bar, volatile LAS unsigned* st) {
    XcdBarrier b; b.bar = bar; b.x = xb_xcc_id(); b.st = st;
    if (threadIdx.x == 0) (void)xb_add(&bar[XB_XCNT(b.x)], 1u);
    return b;
}
__device__ __forceinline__ void xcd_barrier_complete(unsigned* bar, unsigned x, unsigned& nloc, unsigned& nx) {
    const unsigned G = gridDim.x * gridDim.y * gridDim.z;
    unsigned sum, cnt, mine, sp = 0u;
    for (;;) {
        sum = 0u; cnt = 0u; mine = 0u;
#pragma unroll
        for (unsigned j = 0; j < 16; ++j) { const unsigned c = xb_ld(&bar[XB_XCNT(j)]); sum += c; cnt += (c > 0u) ? 1u : 0u; mine = (j == x) ? c : mine; }
        if (sum == G) break;
        __builtin_amdgcn_s_sleep(1);
        if ((++sp & 255u) == 0u) { if (xb_ld(&bar[XB_TMO])) break; if (sp > XB_SPIN_CAP) { atomicAdd(&bar[XB_TMO], 1u); break; } }
    }
    nloc = mine > 0u ? mine : 1u; nx = cnt > 0u ? cnt : 1u;
}
__device__ __forceinline__ void xcd_barrier(const XcdBarrier& b) {
    asm volatile("s_waitcnt vmcnt(0)" ::: "memory");
    __syncthreads();
    if (threadIdx.x == 0) {
        unsigned* bar = b.bar;
        __builtin_amdgcn_s_waitcnt(0);
        unsigned nloc = b.st[0], nx = b.st[1];
        if (nloc == 0u) { xcd_barrier_complete(bar, b.x, nloc, nx); b.st[0] = nloc; b.st[1] = nx; }
        const unsigned old = xb_add(&bar[XB_XSUB(b.x)], 1u);
        const unsigned gen = old / nloc;
        if (old + 1u == (gen + 1u) * nloc) {
            __builtin_amdgcn_fence(__ATOMIC_RELEASE, "agent");
            asm volatile("s_waitcnt vmcnt(0)" ::: "memory");
            const unsigned og = xb_add(&bar[XB_TOP], 1u);
            const unsigned tg = og / nx;
            if (og + 1u == (tg + 1u) * nx) xb_add(&bar[XB_TOPGEN], 1u);
            else XB_SPIN(xb_ld(&bar[XB_TOPGEN]) == tg, bar);
            __builtin_amdgcn_fence(__ATOMIC_ACQUIRE, "agent");
            xb_add(&bar[XB_XGEN(b.x)], 1u);
            asm volatile("s_waitcnt vmcnt(0)" ::: "memory");
        } else {
            XB_SPIN(xb_ld(&bar[XB_XGEN(b.x)]) == gen, bar);
            __builtin_amdgcn_fence(__ATOMIC_ACQUIRE, "agent");
            asm volatile("s_waitcnt vmcnt(0)" ::: "memory");
        }
    }
    __syncthreads();
}

struct Args { const float* in[28]; float* out; unsigned char* ws; int ph_lo, ph_hi; };
enum { I_X = 0, I_C, I_CTX, I_CCTX, I_WADA, I_BADA, I_GN1, I_GN2, I_WIN, I_WDW, I_BDW, I_LNG, I_LNB, I_LQ1, I_LK1, I_LQ2, I_LK2, I_GSUB, I_SINK, I_WOUT,
       I_FFG, I_FFU, I_FFD, I_WR, I_EXG, I_EXU, I_EXD, I_GFIN };

__device__ __forceinline__ void transpose_item(const float* __restrict__ W, int K, int N, bf16_t* __restrict__ WT, int k0, int n0, int drow0, LAS float* scr, int lane) {
    const int r = lane >> 4, c4 = (lane & 15) * 4;
    f32x4 v[16];
#pragma unroll
    for (int i = 0; i < 16; ++i) v[i] = __builtin_nontemporal_load((const f32x4*)(W + (size_t)(k0 + 4 * i + r) * N + n0 + c4));
#pragma unroll
    for (int i = 0; i < 16; ++i) { LAS float* s = scr + (4 * i + r) * 65 + c4; s[0] = v[i][0]; s[1] = v[i][1]; s[2] = v[i][2]; s[3] = v[i][3]; }
    asm volatile("s_waitcnt lgkmcnt(0)" ::: "memory");
    const int c = lane & 7, nn = lane >> 3;
#pragma unroll
    for (int j = 0; j < 8; ++j) { const int n = nn + 8 * j; const LAS float* s = scr + (8 * c) * 65 + n;
        u32x4 o; o.x = cvtpk(s[0], s[65]); o.y = cvtpk(s[2 * 65], s[3 * 65]); o.z = cvtpk(s[4 * 65], s[5 * 65]); o.w = cvtpk(s[6 * 65], s[7 * 65]);
        *(u32x4*)(WT + (size_t)(drow0 + n) * K + k0 + 8 * c) = o; }
    asm volatile("s_waitcnt lgkmcnt(0)" ::: "memory");
}

__device__ __forceinline__ float quant_row_i8(const f32x4 (&o)[8], signed char* dst, int lane) {
    float am = 0.f;
#pragma unroll
    for (int j = 0; j < 8; ++j) am = fmaxf(fmaxf(am, fmaxf(fabsf(o[j][0]), fabsf(o[j][1]))), fmaxf(fabsf(o[j][2]), fabsf(o[j][3])));
#pragma unroll
    for (int off = 1; off < 64; off <<= 1) am = fmaxf(am, __shfl_xor(am, off));
    const float inv = am > 0.f ? 127.f / am : 0.f;
#pragma unroll
    for (int j = 0; j < 8; ++j) { const int b0 = (int)__builtin_rintf(o[j][0] * inv), b1 = (int)__builtin_rintf(o[j][1] * inv), b2 = (int)__builtin_rintf(o[j][2] * inv), b3 = (int)__builtin_rintf(o[j][3] * inv);
        ((unsigned*)dst)[64 * j + lane] = (unsigned)(b0 & 255) | ((unsigned)(b1 & 255) << 8) | ((unsigned)(b2 & 255) << 16) | ((unsigned)(b3 & 255) << 24); }
    return am * (1.f / 127.f);
}
__device__ __forceinline__ void quant_hidden_rows(bf16_t* HM, const unsigned* rmx, float* hqs, int rows, int gw, int NGW, int lane) {
    for (int row = gw; row < rows; row += NGW) {
        const float am = __uint_as_float(rmx[row]); const float inv = am > 0.f ? 127.f / am : 0.f;
        const u32x4* src = (const u32x4*)(HM + (size_t)row * DFF); u32x2* dst = (u32x2*)(HM + (size_t)row * DFF);
        u32x4 v[11];
#pragma unroll
        for (int i = 0; i < 11; ++i) v[i] = src[lane + 64 * i];
#pragma unroll
        for (int i = 0; i < 11; ++i) { unsigned o[2];
#pragma unroll
            for (int h = 0; h < 2; ++h) { const unsigned w0 = v[i][2 * h], w1 = v[i][2 * h + 1];
                int b0 = (int)__builtin_rintf(bf_lo(w0) * inv), b1 = (int)__builtin_rintf(bf_hi(w0) * inv), b2 = (int)__builtin_rintf(bf_lo(w1) * inv), b3 = (int)__builtin_rintf(bf_hi(w1) * inv);
                b0 = b0 > 127 ? 127 : (b0 < -127 ? -127 : b0); b1 = b1 > 127 ? 127 : (b1 < -127 ? -127 : b1); b2 = b2 > 127 ? 127 : (b2 < -127 ? -127 : b2); b3 = b3 > 127 ? 127 : (b3 < -127 ? -127 : b3);
                o[h] = (unsigned)(b0 & 255) | ((unsigned)(b1 & 255) << 8) | ((unsigned)(b2 & 255) << 16) | ((unsigned)(b3 & 255) << 24); }
            dst[lane + 64 * i] = (u32x2){o[0], o[1]}; }
        if (lane == 0) hqs[row] = am * (1.f / 127.f);
    }
}
__device__ __forceinline__ void sincos_d(double a, float& c, float& s) {
    const double TWO_PI = 6.283185307179586476925286766559;
    const double n = __builtin_rint(a / TWO_PI); const double r = a - n * TWO_PI; const double r2 = r * r;
    double sc = 1.0, ss = 1.0;
    sc = 1.0; ss = 1.0;
#pragma unroll
    for (int k = 13; k >= 1; --k) { ss = 1.0 - r2 / (double)((2 * k) * (2 * k + 1)) * ss; sc = 1.0 - r2 / (double)((2 * k - 1) * (2 * k)) * sc; }
    c = (float)sc; s = (float)(r * ss);
}

constexpr int PH_P0 = 0, PH_L0 = 1, PH_L1 = 12, PH_END = 23;
__host__ __device__ constexpr bool phase_valid(int p) { return p >= 0 && p < PH_END && !(p == 10 || p == 11); }
typedef const __attribute__((address_space(4))) Args* CArgs;
__device__ __forceinline__ void strip_k2048(const float* __restrict__ W, int N, int n0, signed char* __restrict__ W8, float* __restrict__ wsc, int drow0, LAS unsigned char* lds, int tid, float wmul = 1.f) {
    constexpr int SP = 4112;
    const int lane = tid & 63, wave = tid >> 6;
    LAS unsigned char* img = lds;
    LAS float* red2 = (LAS float*)(lds + 32 * SP);
    LAS float* scl2 = red2 + 256;
    const int kp = lane >> 3, c4 = (lane & 7) * 4;
    f32x4 mx = {0.f, 0.f, 0.f, 0.f};
    f32x4 ra[8], rb[8];
#pragma unroll
    for (int it = 0; it < 8; ++it) { const int k = 256 * wave + 16 * it + 2 * kp;
        ra[it] = __builtin_nontemporal_load((const f32x4*)(W + (size_t)k * N + n0 + c4)); rb[it] = __builtin_nontemporal_load((const f32x4*)(W + (size_t)(k + 1) * N + n0 + c4)); }
#pragma unroll
    for (int it = 0; it < 16; ++it) { const int k = 256 * wave + 16 * it + 2 * kp; const f32x4 a = ra[it & 7], bq = rb[it & 7];
        if (it + 8 < 16) { const int k2 = k + 128;
            ra[it & 7] = __builtin_nontemporal_load((const f32x4*)(W + (size_t)k2 * N + n0 + c4)); rb[it & 7] = __builtin_nontemporal_load((const f32x4*)(W + (size_t)(k2 + 1) * N + n0 + c4)); }
#pragma unroll
        for (int i = 0; i < 4; ++i) { mx[i] = fmaxf(mx[i], fmaxf(fabsf(a[i]), fabsf(bq[i]))); *(LAS unsigned*)(img + (c4 + i) * SP + k * 2) = cvtpk(a[i], bq[i]); } }
#pragma unroll
    for (int i = 0; i < 4; ++i) { mx[i] = fmaxf(mx[i], __shfl_xor(mx[i], 8)); mx[i] = fmaxf(mx[i], __shfl_xor(mx[i], 16)); mx[i] = fmaxf(mx[i], __shfl_xor(mx[i], 32)); }
    if (lane < 8) { red2[wave * 32 + c4 + 0] = mx[0]; red2[wave * 32 + c4 + 1] = mx[1]; red2[wave * 32 + c4 + 2] = mx[2]; red2[wave * 32 + c4 + 3] = mx[3]; }
    __syncthreads();
    if (tid < 32) { float m = 0.f;
#pragma unroll
        for (int w = 0; w < 8; ++w) m = fmaxf(m, red2[w * 32 + tid]);
        scl2[tid] = m > 0.f ? 127.f / m : 0.f; wsc[drow0 + tid] = m * (1.f / 127.f) * wmul; }
    __syncthreads();
#pragma unroll 2
    for (int q = 0; q < 8; ++q) { const int p = tid + 512 * q, n = p >> 7, ch = p & 127; const float inv = scl2[n];
        const u32x4 w0 = *(const LAS u32x4*)(img + n * SP + ch * 32), w1 = *(const LAS u32x4*)(img + n * SP + ch * 32 + 16);
        unsigned o[4];
#pragma unroll
        for (int h = 0; h < 2; ++h) { const unsigned d0 = h == 0 ? w0.x : w0.z, d1 = h == 0 ? w0.y : w0.w, e0 = h == 0 ? w1.x : w1.z, e1 = h == 0 ? w1.y : w1.w;
            const int b0 = (int)__builtin_rintf(bf_lo(d0) * inv), b1 = (int)__builtin_rintf(bf_hi(d0) * inv), b2 = (int)__builtin_rintf(bf_lo(d1) * inv), b3 = (int)__builtin_rintf(bf_hi(d1) * inv);
            const int g0 = (int)__builtin_rintf(bf_lo(e0) * inv), g1 = (int)__builtin_rintf(bf_hi(e0) * inv), g2 = (int)__builtin_rintf(bf_lo(e1) * inv), g3 = (int)__builtin_rintf(bf_hi(e1) * inv);
            o[h] = (unsigned)(b0 & 255) | ((unsigned)(b1 & 255) << 8) | ((unsigned)(b2 & 255) << 16) | ((unsigned)(b3 & 255) << 24);
            o[2 + h] = (unsigned)(g0 & 255) | ((unsigned)(g1 & 255) << 8) | ((unsigned)(g2 & 255) << 16) | ((unsigned)(g3 & 255) << 24); }
        *(u32x4*)(W8 + (size_t)(drow0 + n) * DM + ch * 16) = (u32x4){o[0], o[1], o[2], o[3]}; }
    __syncthreads();
}
__device__ __forceinline__ void strip_k5632(const float* __restrict__ W, int n0, signed char* __restrict__ W8, float* __restrict__ wsc, LAS unsigned char* lds, int tid) {
    constexpr int N = DM, KT = 11, Kb = 512 * KT;
    const int lane = tid & 63, wave = tid >> 6;
    LAS float* scr = (LAS float*)(lds + wave * 16640);
    LAS float* red = (LAS float*)(lds + 8 * 16640);
    LAS float* scl = red + 512;
    const int r = lane >> 4, c4 = (lane & 15) * 4;
    f32x4 mx = {0.f, 0.f, 0.f, 0.f};
    { const int k0 = 64 * (KT * wave);
#pragma unroll
        for (int i = 0; i < 16; ++i) { const f32x4 v = __builtin_nontemporal_load((const f32x4*)(W + (size_t)(k0 + 4 * i + r) * N + n0 + c4));
            mx[0] = fmaxf(mx[0], fabsf(v[0])); mx[1] = fmaxf(mx[1], fabsf(v[1])); mx[2] = fmaxf(mx[2], fabsf(v[2])); mx[3] = fmaxf(mx[3], fabsf(v[3])); } }
#pragma unroll
    for (int i = 0; i < 4; ++i) { mx[i] = fmaxf(mx[i], __shfl_xor(mx[i], 16)); mx[i] = fmaxf(mx[i], __shfl_xor(mx[i], 32)); }
    if (lane < 16) { red[wave * 64 + c4 + 0] = mx[0]; red[wave * 64 + c4 + 1] = mx[1]; red[wave * 64 + c4 + 2] = mx[2]; red[wave * 64 + c4 + 3] = mx[3]; }
    __syncthreads();
    if (tid < 64) { float m = 0.f;
#pragma unroll
        for (int w = 0; w < 8; ++w) m = fmaxf(m, red[w * 64 + tid]);
        scl[tid] = m > 0.f ? 32.f / m : 1.f; wsc[n0 + tid] = m > 0.f ? m * (1.f / 32.f) : 1.f; }
    __syncthreads();
    for (int t = 0; t < KT; ++t) { const int k0 = 64 * (KT * wave + t);
        f32x4 v[16];
#pragma unroll
        for (int i = 0; i < 16; ++i) v[i] = __builtin_nontemporal_load((const f32x4*)(W + (size_t)(k0 + 4 * i + r) * N + n0 + c4));
#pragma unroll
        for (int i = 0; i < 16; ++i) { LAS float* sp = scr + (4 * i + r) * 65 + c4; sp[0] = v[i][0]; sp[1] = v[i][1]; sp[2] = v[i][2]; sp[3] = v[i][3]; }
        asm volatile("s_waitcnt lgkmcnt(0)" ::: "memory");
        const int c = lane & 3, nn = lane >> 2;
#pragma unroll
        for (int j = 0; j < 4; ++j) { const int n = nn + 16 * j; const float inv = scl[n]; const LAS float* sp = scr + (16 * c) * 65 + n;
            unsigned o[4];
#pragma unroll
            for (int q = 0; q < 4; ++q) { unsigned w = 0u;
                const float x0 = __builtin_amdgcn_fmed3f(sp[(4 * q + 0) * 65] * inv, -440.f, 440.f), x1 = __builtin_amdgcn_fmed3f(sp[(4 * q + 1) * 65] * inv, -440.f, 440.f);
                const float x2 = __builtin_amdgcn_fmed3f(sp[(4 * q + 2) * 65] * inv, -440.f, 440.f), x3 = __builtin_amdgcn_fmed3f(sp[(4 * q + 3) * 65] * inv, -440.f, 440.f);
                w = __builtin_amdgcn_cvt_pk_fp8_f32(x0, x1, w, false); w = __builtin_amdgcn_cvt_pk_fp8_f32(x2, x3, w, true); o[q] = w; }
            *(u32x4*)(W8 + (size_t)(n0 + n) * Kb + k0 + 16 * c) = (u32x4){o[0], o[1], o[2], o[3]}; }
        asm volatile("s_waitcnt lgkmcnt(0)" ::: "memory");
    }
    __syncthreads();
}
constexpr float GLU_GATE_MUL = 1.4426950408889634f, GLU_UP_MUL = 4.f / 1.4426950408889634f;
constexpr int NSA_DN = 32, NSA_IN = 288, NSA_OUT = 128, NSA_GU = 352, NSA = NSA_DN + NSA_IN + NSA_OUT + NSA_GU;
constexpr int NSE_GU = 16 * 176, NSE_DN = 8 * 32, NSE = NSE_GU + NSE_DN;
__device__ __forceinline__ void do_strip_A(CArgs ap, int st, LAS unsigned char* lds, int tid) {
    unsigned char* ws = ap->ws;
    if (st < NSA_DN) { strip_k5632(ap->in[I_FFD], 64 * st, (signed char*)(ws + WS_FF2), (float*)(ws + WS_WSCD), lds, tid); return; }
    st -= NSA_DN;
    if (st < NSA_IN) { const int l = st / 144, sb = st % 144;
        strip_k2048(ap->in[I_WIN] + (size_t)l * DM * DIN, DIN, 32 * sb, (signed char*)(ws + WS_WIN + (size_t)l * (SZ_WIN / 2)), (float*)(ws + WS_WSCIN) + l * DIN, 32 * sb, lds, tid); return; }
    st -= NSA_IN;
    if (st < NSA_OUT) { const int l = st / 64, sb = st % 64;
        strip_k2048(ap->in[I_WOUT] + (size_t)l * DM * DM, DM, 32 * sb, (signed char*)(ws + WS_WOUT + (size_t)l * (SZ_WOUT / 2)), (float*)(ws + WS_WSCO) + l * DM, 32 * sb, lds, tid); return; }
    st -= NSA_OUT;
    { const int up = st / 176, sb = st % 176, n0 = 32 * sb;
      strip_k2048(ap->in[up ? I_FFU : I_FFG], DFF, n0, (signed char*)(ws + WS_FF1), (float*)(ws + WS_WSC1), (n0 / 128) * 256 + (n0 % 128) + (up ? 128 : 0), lds, tid, up ? GLU_UP_MUL : GLU_GATE_MUL); }
}
__device__ __forceinline__ void do_strip_E(CArgs ap, int st, LAS unsigned char* lds, int tid) {
    unsigned char* ws = ap->ws;
    if (st < NSE_GU) { const int mat = st / 176, sb = st % 176, e = mat >> 1, up = mat & 1, n0 = 32 * sb;
        strip_k2048(ap->in[up ? I_EXU : I_EXG] + (size_t)e * DM * DFF, DFF, n0, (signed char*)(ws + WS_EX1 + (size_t)e * (SZ_FF1 / 2)), (float*)(ws + WS_WSCX + (size_t)e * 2 * DFF * 4),
                    (n0 / 128) * 256 + (n0 % 128) + (up ? 128 : 0), lds, tid, up ? GLU_UP_MUL : GLU_GATE_MUL); return; }
    st -= NSE_GU;
    { const int e = st / 32, sb = st % 32;
      strip_k5632(ap->in[I_EXD] + (size_t)e * DFF * DM, 64 * sb, (signed char*)(ws + WS_EX2 + (size_t)e * (SZ_FF2 / 2)), (float*)(ws + WS_WSCD) + (1 + e) * DM, lds, tid); }
}
__device__ __forceinline__ void pull_strips_E(CArgs ap, unsigned* ctr, int lo, int hi, LAS unsigned char* lds, int tid) {
    LAS int* nxt = (LAS int*)(lds + 8 * 16640 + 2048 + 256);
    for (;;) {
        if (tid == 0) nxt[0] = (int)atomicAdd(ctr, 1u);
        __syncthreads();
        const int st = lo + nxt[0];
        __syncthreads();
        if (st >= hi) break;
        do_strip_E(ap, st, lds, tid);
    }
}
constexpr int NRNG = 7;
#ifndef BG_SPLIT
#define BG_SPLIT 1
#endif
#ifndef BG_N0
#define BG_N0 0
#define BG_N1 0
#define BG_N2 0
#define BG_N3 0
#define BG_N4 0
#endif
constexpr int BG_S1 = BG_N0, BG_S2 = BG_S1 + BG_N1, BG_S4 = BG_S2 + BG_N2, BG_S5 = BG_S4 + BG_N4;
__host__ __device__ constexpr int rng_lo(int i) { return i == 0 ? 0 : i == 1 ? BG_S1 : i == 2 ? BG_S2 : i == 3 ? NSE_GU : i == 4 ? BG_S4 : i == 5 ? BG_S5 : NSE_GU + BG_N3; }
__host__ __device__ constexpr int rng_hi(int i) { return i == 0 ? BG_S1 : i == 1 ? BG_S2 : i == 2 ? BG_S4 : i == 3 ? NSE_GU + BG_N3 : i == 4 ? BG_S5 : i == 5 ? NSE_GU : NSE; }
#define BG_PULL(R) pull_strips_E(ap, (unsigned*)(ws + WS_CTL) + 8193 + (R), rng_lo(R), rng_hi(R), lds, tid)
#ifndef DBG_MASK
#define DBG_MASK 0xFFFFFFFFu
#endif
#define IN(k) (((DBG_MASK >> (k)) & 1u) && lo <= (k) && (k) < hi)
#define SEAM(k) do { if (hi > (k) + 1) xcd_barrier(bar); } while (0)
#define REP(k) for (int rep_ = 0; rep_ < ((PROBE_DUP) == (k) ? 2 : 1); ++rep_)
#define PH_ENTER() CArgs ap = (CArgs)__builtin_amdgcn_kernarg_segment_ptr(); asm volatile("" : "+s"(ap)); unsigned char* ws = ap->ws; (void)ws; \
    int tid = threadIdx.x; asm volatile("" : "+v"(tid)); const int lane = tid & 63, wave = __builtin_amdgcn_readfirstlane(tid >> 6); (void)lane; (void)wave; \
    const int gw = vcu * NWAVES + wave, NGW = G * NWAVES; (void)gw; (void)NGW; \
    float* ADA = (float*)(ws + WS_ADA); float* ROPE = (float*)(ws + WS_ROPE); float* LAM = (float*)(ws + WS_LAM); \
    int* CCNT = (int*)(ws + WS_CCNT); unsigned* TOKE = (unsigned*)(ws + WS_TOKE); float* TOKW = (float*)(ws + WS_TOKW); int* TOKP = (int*)(ws + WS_TOKP); \
    bf16_t* H = (bf16_t*)(ws + WS_H); bf16_t* U = (bf16_t*)(ws + WS_U); bf16_t* OC = (bf16_t*)(ws + WS_OC); bf16_t* MIX = (bf16_t*)(ws + WS_MIX); \
    bf16_t* XL = (bf16_t*)(ws + WS_XL); bf16_t* HMID = (bf16_t*)(ws + WS_HMID); bf16_t* HS = (bf16_t*)(ws + WS_HS); bf16_t* Y = (bf16_t*)(ws + WS_Y); \
    const float* ada_l = ADA + (size_t)l * 3 * ADA_N; float* HSC = (float*)(ws + WS_HSC); float* HSS = (float*)(ws + WS_HSS); (void)HSC; (void)HSS; \
    (void)ROPE; (void)LAM; (void)CCNT; (void)TOKE; (void)TOKW; (void)TOKP; (void)H; (void)U; (void)OC; (void)MIX; (void)XL; (void)HMID; (void)HS; (void)Y; (void)ada_l
template <int l>
__device__ __forceinline__ void run_layer(LAS unsigned char* lds, const XcdBarrier& bar, int lo, int hi, int G, int bx, int vcu) {
    {
        const int PB = l == 0 ? PH_L0 : PH_L1;
        REP(PB + 0) if (IN(PB + 0)) {
            PH_ENTER();
            const float* gn = ap->in[I_GN1] + l * DM;
            for (int row = gw; row < MALL; row += NGW) {
                const int b = row / SEG, rr = row - b * SEG; const bool isctx = rr < CTXL;
                const float* xr = isctx ? ap->in[I_CTX] + ((size_t)b * CTXL + rr) * DM : ap->in[I_X] + ((size_t)b * SEQ + rr - CTXL) * DM;
                const bf16_t* xb = XL + (size_t)row * DM;
                const float* shp = ada_l + (isctx ? 2 : b) * ADA_N; const float* scp = shp + DM;
                f32x4 v[8]; float ss = 0.f;
#pragma unroll
                for (int j = 0; j < 8; ++j) { if constexpr (l == 0) v[j] = ((const f32x4*)xr)[64 * j + lane]; else v[j] = ldx4(xb + 4 * (64 * j + lane)); ss += (v[j][0] * v[j][0] + v[j][1] * v[j][1]) + (v[j][2] * v[j][2] + v[j][3] * v[j][3]); }
                const float rstd = 1.f / sqrtf(wave_sum(ss) * (1.f / DM) + NORM_EPS);
#pragma unroll
                for (int j = 0; j < 8; ++j) { const f32x4 g4 = ((const f32x4*)gn)[64 * j + lane], s4 = ((const f32x4*)shp)[64 * j + lane], c4 = ((const f32x4*)scp)[64 * j + lane];
                    v[j] = v[j] * rstd * g4 * (c4 + 1.f) + s4; }
                const float sc = quant_row_i8(v, (signed char*)H + (size_t)row * DM, lane);
                if (lane == 0) HSC[row] = sc;
            }
            SEAM(PB + 0);
        }
        REP(PB + 1) if (IN(PB + 1)) {
            PH_ENTER();
            if (BG_SPLIT && G == 256 && bx >= 240) { BG_PULL(l == 0 ? 0 : 4); }
            else {
            pg8::Gemm g{H, (const bf16_t*)(ws + WS_WIN + (size_t)l * (SZ_WIN / 2)), DM / 2, DM / 2};
            pg8::TileSched S; S.init(MALL / 256, DIN / 256, (BG_SPLIT && G == 256) ? 240 : G, bx, 0, nullptr);
            pg8::EpiInI8 E{U, ROPE, HSC, (const float*)(ws + WS_WSCIN) + l * DIN, ws + WS_VT8};
            pg8::gemm_phase<pg8::EpiInI8, true, 1>(lds, g, S, E);
            }
            SEAM(PB + 1);
        }
        REP(PB + 2) if (IN(PB + 2)) {
            PH_ENTER();
#ifndef DBG_NOBIG
            for (int rp_ = 0; rp_ < ((PROBE_DUP) == 100 + l ? 2 : 1); ++rp_)
            for (int id = vcu; id < 768; id += G) {
                const int combo = id >> 5, qb = id & 31, b = combo / 12, rem = combo % 12, h = rem >> 1, c = rem & 1;
                const unsigned char* seg = (const unsigned char*)U + (size_t)b * SEG * UROWB + Q8_OFF;
                att::attn_unit<128, false>(seg + (size_t)(CTXL + qb * 256) * UROWB + QB_Q + h * 128 + c * 64, seg + QB_K + h * 128 + c * 64, ws + WS_VT8 + ((size_t)b * 1024 + h * 128) * SEG,
                                           132, CTXL, false, 0, 0.f, OC + ((size_t)c * MALL + (size_t)b * SEG + CTXL + qb * 256) * 768 + h * 128, 768, lds);
            }
#endif
#ifndef DBG_NOSWA
            for (int rp_ = 0; rp_ < ((PROBE_DUP) == 102 + l ? 2 : 1); ++rp_)
            for (int s = vcu; s < 768; s += G) {
                const int bh = s >> 5, qb = s & 31, b = bh / 12, qh = bh % 12, kvh = qh / 3, q0 = qb * 256;
                const int ks = q0 - 128 < 0 ? 0 : q0 - 128, ke = q0 + 384 > SEQ ? SEQ : q0 + 384;
                const unsigned char* seg = (const unsigned char*)U + (size_t)b * SEG * UROWB + Q8_OFF;
                att::attn_unit<64, true>(seg + (size_t)(CTXL + q0) * UROWB + QB_CQ + qh * 64, seg + QB_CK + kvh * 64, ws + WS_VT8 + ((size_t)b * 1024 + 768 + kvh * 64) * SEG,
                                         4 + (ke - ks) / 64, CTXL + ks, true, q0 - ks, ap->in[I_SINK][l * 12 + qh],
                                         MIX + ((size_t)b * SEG + CTXL + q0) * DM + MIX_SWA + qh * 64, DM, lds);
            }
#endif
#ifndef DBG_NOCONV
            for (int rp_ = 0; rp_ < ((PROBE_DUP) == 104 + l ? 2 : 1); ++rp_)
            for (int j = vcu; j < (l == 0 ? MALL / 16 : NTOK / 16); j += G) {
                const int row0 = l == 0 ? 16 * j : (j / 512) * SEG + CTXL + (j % 512) * 16;
                const int b = row0 / SEG, rr0 = row0 - b * SEG; const int seg_lo = rr0 < CTXL ? b * SEG : b * SEG + CTXL, seg_hi = rr0 < CTXL ? b * SEG + CTXL : (b + 1) * SEG;
                LAS float* Yl = (LAS float*)lds;
                LAS float* Ol = (LAS float*)(lds + 46 * 512 * 4);
                const int ch = tid, chp = (ch & ~31) + 8 * ((ch >> 2) & 3) + 4 * ((ch >> 4) & 1) + (ch & 3);
#pragma unroll
                for (int tb = 0; tb < 46; tb += 23) {
                    unsigned short av[23], gv[23];
#pragma unroll
                    for (int t = 0; t < 23; ++t) { const int row = row0 - 15 + tb + t; const int rc = row < seg_lo ? seg_lo : (row >= seg_hi ? seg_hi - 1 : row);
                        av[t] = U[(size_t)rc * DIN + chp]; gv[t] = U[(size_t)rc * DIN + 512 + chp]; }
#pragma unroll
                    for (int t = 0; t < 23; ++t) { const int row = row0 - 15 + tb + t; const float a = __uint_as_float((unsigned)av[t] << 16), gt = __uint_as_float((unsigned)gv[t] << 16);
                        Yl[(tb + t) * 512 + ch] = (row >= seg_lo && row < seg_hi) ? a * fsigmoid(gt) : 0.f; }
                }
                float wk[31];
#pragma unroll
                for (int k = 0; k < 31; ++k) wk[k] = ap->in[I_WDW][(size_t)l * 31 * 512 + k * 512 + ch];
                const float bias = ap->in[I_BDW][l * 512 + ch];
                float oacc[16];
#pragma unroll
                for (int t = 0; t < 16; ++t) oacc[t] = bias;
                asm volatile("s_waitcnt lgkmcnt(0)" ::: "memory");
#pragma unroll
                for (int sidx = 0; sidx < 46; ++sidx) { const float yv = Yl[sidx * 512 + ch];
#pragma unroll
                    for (int t = 0; t < 16; ++t) { const int k = sidx - t; if (k >= 0 && k < 31) oacc[t] += wk[k] * yv; } }
#pragma unroll
                for (int t = 0; t < 16; ++t) Ol[t * 512 + ch] = oacc[t];
                __syncthreads();
                for (int t = wave * 2; t < wave * 2 + 2; ++t) {
                    const f32x4 v0 = *(const LAS f32x4*)(Ol + t * 512 + 8 * lane), v1 = *(const LAS f32x4*)(Ol + t * 512 + 8 * lane + 4);
                    const float mean = wave_sum((v0[0] + v0[1]) + (v0[2] + v0[3]) + (v1[0] + v1[1]) + (v1[2] + v1[3])) * (1.f / 512.f);
                    const f32x4 d0 = v0 - mean, d1 = v1 - mean;
                    const float var = wave_sum((d0[0] * d0[0] + d0[1] * d0[1]) + (d0[2] * d0[2] + d0[3] * d0[3]) + (d1[0] * d1[0] + d1[1] * d1[1]) + (d1[2] * d1[2] + d1[3] * d1[3])) * (1.f / 512.f);
                    const float rstd = 1.f / sqrtf(var + NORM_EPS);
                    const f32x4 g0 = *(const f32x4*)(ap->in[I_LNG] + l * 512 + 8 * lane), g1 = *(const f32x4*)(ap->in[I_LNG] + l * 512 + 8 * lane + 4);
                    const f32x4 b0 = *(const f32x4*)(ap->in[I_LNB] + l * 512 + 8 * lane), b1 = *(const f32x4*)(ap->in[I_LNB] + l * 512 + 8 * lane + 4);
                    const f32x4 y0 = d0 * rstd * g0 + b0, y1 = d1 * rstd * g1 + b1;
                    u32x4 w; w.x = cvtpk(fsilu(y0[0]), fsilu(y0[1])); w.y = cvtpk(fsilu(y0[2]), fsilu(y0[3])); w.z = cvtpk(fsilu(y1[0]), fsilu(y1[1])); w.w = cvtpk(fsilu(y1[2]), fsilu(y1[3]));
                    *(u32x4*)(MIX + (size_t)(row0 + t) * DM + 8 * lane) = w;
                }
                __syncthreads();
            }
#endif
#ifndef DBG_NOCTX
            if (l == 0) {
                for (int j = (vcu + G - 32 % G) % G; j < 24; j += G) {
                    const int b = j / 12, rem = j % 12, h = rem >> 1, c = rem & 1; const unsigned char* seg = (const unsigned char*)U + (size_t)b * SEG * UROWB + Q8_OFF;
                    att::attn_unit<128, false>(seg + QB_Q + h * 128 + c * 64, seg + QB_K + h * 128 + c * 64, ws + WS_VT8 + ((size_t)b * 1024 + h * 128) * SEG,
                                               4, CTXL, false, 0, 0.f, OC + ((size_t)c * MALL + (size_t)b * SEG) * 768 + h * 128, 768, lds);
                }
                for (int j = (vcu + G - 64 % G) % G; j < 24; j += G) {
                    const int b = j / 12, qh = j % 12, kvh = qh / 3; const unsigned char* seg = (const unsigned char*)U + (size_t)b * SEG * UROWB + Q8_OFF;
                    att::attn_unit<64, true>(seg + QB_CQ + qh * 64, seg + QB_CK + kvh * 64, ws + WS_VT8 + ((size_t)b * 1024 + 768 + kvh * 64) * SEG,
                                             4, CTXL, false, 0, ap->in[I_SINK][l * 12 + qh], MIX + (size_t)b * SEG * DM + MIX_SWA + qh * 64, DM, lds);
                }
            }
#endif
            SEAM(PB + 2);
        }
        REP(PB + 3) if (IN(PB + 3)) {
            PH_ENTER();
            const float lam = LAM[l]; const float post = 1.f - (l == 0 ? 0.2f : (float)(0.8 - 0.6 * 0.74081822068171786607));
            const float* gs = ap->in[I_GSUB] + l * 128;
            float* MXS = (float*)(ws + WS_MXS);
            for (int row = gw; row < MALL; row += NGW) {
                if (l == 1 && (row % SEG) < CTXL) continue;
                const u32x4 cvp = ((const u32x4*)(MIX + (size_t)row * DM))[lane];
                u32x2 swp[3];
#pragma unroll
                for (int j = 0; j < 3; ++j) swp[j] = *(const u32x2*)(MIX + (size_t)row * DM + MIX_SWA + 4 * (64 * j + lane));
                const bf16_t* o1 = OC + (size_t)row * 768; const bf16_t* o2 = OC + ((size_t)MALL + row) * 768;
                f32x4 dv[3];
#pragma unroll
                for (int j = 0; j < 3; ++j) { const int q = 64 * j + lane; const f32x4 a = ldx4(o1 + 4 * q), bq = ldx4(o2 + 4 * q); const f32x4 d = a - bq * lam;
                    float ss = (d[0] * d[0] + d[1] * d[1]) + (d[2] * d[2] + d[3] * d[3]);
                    ss += __shfl_xor(ss, 1); ss += __shfl_xor(ss, 2); ss += __shfl_xor(ss, 4); ss += __shfl_xor(ss, 8); ss += __shfl_xor(ss, 16);
                    const float rs = post / sqrtf(ss * (1.f / 128.f) + NORM_EPS);
                    const f32x4 g4 = *(const f32x4*)(gs + 4 * (lane & 31)); dv[j] = d * rs * g4; }
                f32x4 c0 = {bf_lo(cvp.x), bf_hi(cvp.x), bf_lo(cvp.y), bf_hi(cvp.y)}, c1 = {bf_lo(cvp.z), bf_hi(cvp.z), bf_lo(cvp.w), bf_hi(cvp.w)};
                f32x4 sv[3];
#pragma unroll
                for (int j = 0; j < 3; ++j) sv[j] = (f32x4){bf_lo(swp[j].x), bf_hi(swp[j].x), bf_lo(swp[j].y), bf_hi(swp[j].y)};
                float am = 0.f;
#pragma unroll
                for (int i = 0; i < 4; ++i) { am = fmaxf(am, fmaxf(fabsf(c0[i]), fabsf(c1[i])));
#pragma unroll
                    for (int j = 0; j < 3; ++j) am = fmaxf(am, fmaxf(fabsf(dv[j][i]), fabsf(sv[j][i]))); }
#pragma unroll
                for (int off = 1; off < 64; off <<= 1) am = fmaxf(am, __shfl_xor(am, off));
                const float inv = am > 0.f ? 127.f / am : 0.f;
                signed char* dst = (signed char*)(MIX + (size_t)row * DM);
#define Q4(v) ((unsigned)((int)__builtin_rintf((v)[0] * inv) & 255) | ((unsigned)((int)__builtin_rintf((v)[1] * inv) & 255) << 8) | ((unsigned)((int)__builtin_rintf((v)[2] * inv) & 255) << 16) | ((unsigned)((int)__builtin_rintf((v)[3] * inv) & 255) << 24))
                *(u32x2*)(dst + 8 * lane) = (u32x2){Q4(c0), Q4(c1)};
#pragma unroll
                for (int j = 0; j < 3; ++j) { *(unsigned*)(dst + MIX_DIFF + 4 * (64 * j + lane)) = Q4(dv[j]); *(unsigned*)(dst + MIX_SWA + 4 * (64 * j + lane)) = Q4(sv[j]); }
#undef Q4
                if (lane == 0) MXS[row] = am * (1.f / 127.f);
            }
            SEAM(PB + 3);
        }
        REP(PB + 4) if (IN(PB + 4)) {
            PH_ENTER();
            pg8::Gemm g{MIX, (const bf16_t*)(ws + WS_WOUT + (size_t)l * (SZ_WOUT / 2)), DM / 2, DM};
            const bool bgmode = (BG_SPLIT && l == 0 && G == 256);
            if (bgmode && bx >= 176) { BG_PULL(1); }
            else {
            pg8::TileSched S; S.init(l == 0 ? MALL / 256 : NTOK / 256, DM / 256, bgmode ? 176 : G, bx, l == 0 ? 0 : 1, nullptr);
            pg8::EpiResI8 E{XL, ada_l, 2 * DM, (const float*)(ws + WS_MXS), (const float*)(ws + WS_WSCO) + l * DM, ap->in[I_X], ap->in[I_CTX], l == 0 ? 1 : 0};
            pg8::gemm_phase<pg8::EpiResI8, true, 1>(lds, g, S, E);
            }
            SEAM(PB + 4);
        }
        if constexpr (l == 0) {
            REP(PB + 5) if (IN(PB + 5)) {
            PH_ENTER();
                const float* gn = ap->in[I_GN2] + l * DM;
                for (int row = gw; row < MALL; row += NGW) {
                    const int b = row / SEG, rr = row - b * SEG; const bool isctx = rr < CTXL;
                    const bf16_t* xr = XL + (size_t)row * DM;
                    const float* shp = ada_l + (isctx ? 2 : b) * ADA_N + 3 * DM; const float* scp = shp + DM;
                    f32x4 v[8]; float ss = 0.f;
#pragma unroll
                    for (int j = 0; j < 8; ++j) { v[j] = ldx4(xr + 4 * (64 * j + lane)); ss += (v[j][0] * v[j][0] + v[j][1] * v[j][1]) + (v[j][2] * v[j][2] + v[j][3] * v[j][3]); }
                    const float rstd = 1.f / sqrtf(wave_sum(ss) * (1.f / DM) + NORM_EPS);
#pragma unroll
                    for (int j = 0; j < 8; ++j) { const f32x4 g4 = ((const f32x4*)gn)[64 * j + lane], s4 = ((const f32x4*)shp)[64 * j + lane], c4 = ((const f32x4*)scp)[64 * j + lane];
                        v[j] = v[j] * rstd * g4 * (c4 + 1.f) + s4; }
                    const float sc = quant_row_i8(v, (signed char*)H + (size_t)row * DM, lane);
                    if (lane == 0) HSC[row] = sc;
                }
                SEAM(PB + 5);
            }
            REP(PB + 6) if (IN(PB + 6)) {
            PH_ENTER();
                pg8::Gemm g{H, (const bf16_t*)(ws + WS_FF1), DM / 2, DM / 2};
                if (BG_SPLIT && G == 256 && bx >= 248) { BG_PULL(2); }
                else {
                pg8::TileSched S; S.init(MALL / 256, 2 * DFF / 256, (BG_SPLIT && G == 256) ? 248 : G, bx, 0, nullptr);
                pg8::EpiGluI8 E{(unsigned char*)HMID, HSC, (const float*)(ws + WS_WSC1)};
                pg8::gemm_phase<pg8::EpiGluI8, true, 1>(lds, g, S, E);
                }
                SEAM(PB + 6);
            }
            REP(PB + 8) if (IN(PB + 8)) {
            PH_ENTER();
                pg8::Gemm g{HMID, (const bf16_t*)(ws + WS_FF2), DFF / 2, DFF / 2};
                if (BG_SPLIT && G == 256 && bx >= 176) { BG_PULL(3); }
                else {
                pg8::TileSched S; S.init(MALL / 256, DM / 256, (BG_SPLIT && G == 256) ? 176 : G, bx, 0, nullptr);
                pg8::EpiResF8 E{XL, ada_l, 5 * DM, (const float*)(ws + WS_WSCD)};
                pg8::gemm_phase<pg8::EpiResF8, true, 2>(lds, g, S, E);
                }
                SEAM(PB + 8);
            }
        } else {
            REP(PB + 5) if (IN(PB + 5)) {
            PH_ENTER();
                { BG_PULL(3); BG_PULL(6); BG_PULL(0); BG_PULL(1); BG_PULL(2); BG_PULL(4); BG_PULL(5); }
                __syncthreads();
                LAS float* wrT = (LAS float*)lds;
                LAS int* hist = (LAS int*)(lds + 8 * 2048 * 4);
                for (int i = tid; i < 8 * DM; i += 512) { const int e = i / DM, k = i % DM; wrT[i] = ap->in[I_WR][k * 8 + e]; }
                if (tid < 8) hist[tid] = 0;
                __syncthreads();
                const float* gn = ap->in[I_GN2] + l * DM;
                for (int ck = bx; ck < 256; ck += G) {
#pragma unroll 1
                    for (int ti = 0; ti < 8; ++ti) {
                        int lane = tid & 63; asm volatile("" : "+v"(lane));
                        const int tok = ck * 64 + wave * 8 + ti, b = tok / SEQ, row = tok + CTXL * (b + 1);
                        const bf16_t* xr = XL + (size_t)row * DM; const float* shp = ada_l + b * ADA_N + 3 * DM; const float* scp = shp + DM;
                        f32x4 v[8]; float ss = 0.f;
#pragma unroll
                        for (int j = 0; j < 8; ++j) { v[j] = ldx4(xr + 4 * (64 * j + lane)); ss += (v[j][0] * v[j][0] + v[j][1] * v[j][1]) + (v[j][2] * v[j][2] + v[j][3] * v[j][3]); }
                        const float rstd = 1.f / sqrtf(wave_sum(ss) * (1.f / DM) + NORM_EPS);
                        float lg[8];
#pragma unroll
                        for (int e = 0; e < 8; ++e) lg[e] = 0.f;
#pragma unroll
                        for (int j = 0; j < 8; ++j) { const f32x4 g4 = ((const f32x4*)gn)[64 * j + lane], s4 = ((const f32x4*)shp)[64 * j + lane], c4 = ((const f32x4*)scp)[64 * j + lane];
                            const f32x4 o = v[j] * rstd * g4 * (c4 + 1.f) + s4; v[j] = o;
#pragma unroll
                            for (int e = 0; e < 8; ++e) { const f32x4 wv = *(const LAS f32x4*)(wrT + e * DM + 4 * (64 * j + lane)); lg[e] += (o[0] * wv[0] + o[1] * wv[1]) + (o[2] * wv[2] + o[3] * wv[3]); } }
#pragma unroll
                        for (int e = 0; e < 8; ++e) lg[e] = wave_sum(lg[e]);
                        { const float sc = quant_row_i8(v, (signed char*)H + (size_t)row * DM, lane); if (lane == 0) HSC[row] = sc; }
                        int e0 = 0; float v0 = lg[0];
#pragma unroll
                        for (int e = 1; e < 8; ++e) if (lg[e] > v0) { v0 = lg[e]; e0 = e; }
                        int e1 = -1; float v1 = -3.0e38f;
#pragma unroll
                        for (int e = 0; e < 8; ++e) if (e != e0 && lg[e] > v1) { v1 = lg[e]; e1 = e; }
                        const float ex = expf(v1 - v0), w0 = 1.f / (1.f + ex), w1 = ex / (1.f + ex);
                        if (lane == 0) { TOKE[tok] = (unsigned)e0 | ((unsigned)e1 << 8); TOKW[2 * tok] = w0; TOKW[2 * tok + 1] = w1; atomicAdd((int*)&hist[e0], 1); atomicAdd((int*)&hist[e1], 1); }
                    }
                    __syncthreads();
                    if (tid < 8) { CCNT[ck * 8 + tid] = hist[tid]; hist[tid] = 0; }
                    __syncthreads();
                }
                SEAM(PB + 5);
            }
            LAS int* m_tot = (LAS int*)(lds + MISC_OFF + 256);
            LAS int* m_seg = m_tot + 8;
            LAS int* m_pre = m_seg + 8;
            LAS int* m_nt = m_pre + 8;
            LAS unsigned char* m_te = (LAS unsigned char*)(m_nt + 4);
            LAS int* m_part = (LAS int*)(lds + MISC_OFF + 1024);
            REP(PB + 6) if (IN(PB + 6)) {
            PH_ENTER();
                for (int ck = bx; ck < 256; ck += G) {
                    { const int e = tid & 7, cg = tid >> 3; int s = 0, sp = 0;
#pragma unroll
                      for (int q = 0; q < 4; ++q) { const int c = 4 * cg + q; const int v = CCNT[c * 8 + e]; s += v; if (c < ck) sp += v; }
                      m_part[cg * 8 + e] = s; m_part[512 + cg * 8 + e] = sp; }
                    __syncthreads();
                    if (tid < 8) { int s = 0, sp = 0; for (int q = 0; q < 64; ++q) { s += m_part[q * 8 + tid]; sp += m_part[512 + q * 8 + tid]; } m_tot[tid] = s; m_pre[tid] = sp; }
                    __syncthreads();
                    if (tid == 0) { int acc = 0; for (int e = 0; e < 8; ++e) { m_seg[e] = acc; acc += (m_tot[e] + 255) & ~255; }
                        LAS int* posl = (LAS int*)lds;
                        for (int i = 0; i < 64; ++i) { const int tok = ck * 64 + i; const unsigned ee = TOKE[tok]; const int e0 = ee & 255, e1 = ee >> 8;
                            const int p0 = m_seg[e0] + m_pre[e0]; m_pre[e0]++; const int p1 = m_seg[e1] + m_pre[e1]; m_pre[e1]++;
                            posl[2 * i] = p0; posl[2 * i + 1] = p1; TOKP[2 * tok] = p0; TOKP[2 * tok + 1] = p1; } }
                    __syncthreads();
                    { const LAS int* posl = (const LAS int*)lds;
                      for (int ti = 0; ti < 8; ++ti) { const int i = wave * 8 + ti, tok = ck * 64 + i, b = tok / SEQ, row = tok + CTXL * (b + 1);
                        const int p0 = posl[2 * i], p1 = posl[2 * i + 1];
                        const u32x4* src = (const u32x4*)((const signed char*)H + (size_t)row * DM); u32x4* d0 = (u32x4*)((signed char*)HS + (size_t)p0 * DM); u32x4* d1 = (u32x4*)((signed char*)HS + (size_t)p1 * DM);
#pragma unroll
                        for (int q = 0; q < 2; ++q) { const u32x4 v = src[64 * q + lane]; d0[64 * q + lane] = v; d1[64 * q + lane] = v; }
                        if (lane == 0) { const float sc = HSC[row]; HSS[p0] = sc; HSS[p1] = sc; } } }
                    __syncthreads();
                }
                SEAM(PB + 6);
            }
            if (IN(PB + 7) || IN(PB + 8) || IN(PB + 9)) {
                PH_ENTER();
                { const int e = tid & 7, cg = tid >> 3; int s = 0;
#pragma unroll
                  for (int q = 0; q < 4; ++q) s += CCNT[(4 * cg + q) * 8 + e];
                  m_part[cg * 8 + e] = s; }
                __syncthreads();
                if (tid < 8) { int s = 0; for (int q = 0; q < 64; ++q) s += m_part[q * 8 + tid]; m_tot[tid] = s; }
                __syncthreads();
                if (tid == 0) { int nt = 0; for (int e = 0; e < 8; ++e) { const int n = (m_tot[e] + 255) >> 8; for (int q = 0; q < n; ++q) m_te[nt + q] = (unsigned char)e; nt += n; } m_nt[0] = nt; }
                __syncthreads();
            }
            REP(PB + 7) if (IN(PB + 7)) {
            PH_ENTER();
                pg8::Gemm g{HS, (const bf16_t*)(ws + WS_EX1), DM / 2, DM / 2};
                pg8::TileSched S; S.init(m_nt[0], 2 * DFF / 256, G, bx, 2, m_te);
                pg8::EpiGluI8 E{(unsigned char*)HMID, HSS, (const float*)(ws + WS_WSCX)};
                pg8::gemm_phase<pg8::EpiGluI8, true, 1>(lds, g, S, E);
                SEAM(PB + 7);
            }
            REP(PB + 9) if (IN(PB + 9)) {
            PH_ENTER();
                pg8::Gemm g{HMID, (const bf16_t*)(ws + WS_EX2), DFF / 2, DFF / 2};
                pg8::TileSched S; S.init(m_nt[0], DM / 256, G, bx, 2, m_te);
                pg8::EpiBf16F8 E{Y, (const float*)(ws + WS_WSCD) + DM};
                pg8::gemm_phase<pg8::EpiBf16F8, true, 2>(lds, g, S, E);
                SEAM(PB + 9);
            }
            REP(PB + 10) if (IN(PB + 10)) {
            PH_ENTER();
                const float* gf = ap->in[I_GFIN];
                for (int tok = gw; tok < NTOK; tok += NGW) {
                    const int b = tok / SEQ, row = tok + CTXL * (b + 1);
                    const bf16_t* xr = XL + (size_t)row * DM; const float* gt = ada_l + b * ADA_N + 5 * DM;
                    const int p0 = TOKP[2 * tok], p1 = TOKP[2 * tok + 1]; const float w0 = TOKW[2 * tok], w1 = TOKW[2 * tok + 1];
                    const u32x2* y0 = (const u32x2*)(Y + (size_t)p0 * DM); const u32x2* y1 = (const u32x2*)(Y + (size_t)p1 * DM);
                    f32x4 v[8]; float ss = 0.f;
#pragma unroll
                    for (int j = 0; j < 8; ++j) { const f32x4 xv = ldx4(xr + 4 * (64 * j + lane)), g4 = ((const f32x4*)gt)[64 * j + lane]; const u32x2 a = y0[64 * j + lane], c = y1[64 * j + lane];
                        const f32x4 ya = {bf_lo(a.x), bf_hi(a.x), bf_lo(a.y), bf_hi(a.y)}, yc = {bf_lo(c.x), bf_hi(c.x), bf_lo(c.y), bf_hi(c.y)};
                        v[j] = xv + g4 * (ya * w0 + yc * w1); ss += (v[j][0] * v[j][0] + v[j][1] * v[j][1]) + (v[j][2] * v[j][2] + v[j][3] * v[j][3]); }
                    const float rstd = 1.f / sqrtf(wave_sum(ss) * (1.f / DM) + NORM_EPS);
                    f32x4* op = (f32x4*)(ap->out + (size_t)tok * DM);
#pragma unroll
                    for (int j = 0; j < 8; ++j) __builtin_nontemporal_store(v[j] * rstd * ((const f32x4*)gf)[64 * j + lane], op + 64 * j + lane);
                }
            }
        }
        }
}

__global__ void __launch_bounds__(512, 2) fwd(Args args) {
    extern __shared__ __attribute__((aligned(16))) unsigned char lds_raw[];
    LAS unsigned char* lds = (LAS unsigned char*)lds_raw;
    volatile LAS unsigned* MISC = (volatile LAS unsigned*)(lds + MISC_OFF);
    const int tid = threadIdx.x, lane = tid & 63, wave = __builtin_amdgcn_readfirstlane(tid >> 6);
    const int G = gridDim.x, bx = blockIdx.x;
    const int vcu = (G % 8 == 0) ? (bx % 8) * (G / 8) + bx / 8 : bx;
    const int gw = vcu * NWAVES + wave, NGW = G * NWAVES;
    unsigned char* ws = args.ws;
    const int lo = args.ph_lo, hi = args.ph_hi;
    for (int u = tid; u < (LDS_BYTES - MISC_OFF) / 4; u += 512) ((LAS unsigned*)(lds + MISC_OFF))[u] = 0u;
    __syncthreads();
    XcdBarrier bar; bar.bar = (unsigned*)(ws + WS_CTL); bar.x = 0; bar.st = nullptr;
    if (hi - lo > 1) bar = xcd_barrier_post((unsigned*)(ws + WS_CTL), MISC + 8);

    float* ADA = (float*)(ws + WS_ADA); float* ROPE = (float*)(ws + WS_ROPE); float* LAM = (float*)(ws + WS_LAM);

    REP(PH_P0) if (IN(PH_P0)) {
        LAS float* sv = (LAS float*)lds;
        LAS float* red = (LAS float*)(lds + 3 * 2048 * 4);
        for (int i = tid; i < 3 * DM; i += 512) { const int r = i / DM, k = i % DM; const float v = r < 2 ? args.in[I_C][r * DM + k] : args.in[I_CCTX][k]; sv[i] = fsilu(v); }
        __syncthreads();
        for (int it = vcu; it < 768; it += G) {
            const int l = it / 384, g = it % 384; const float* W = args.in[I_WADA] + (size_t)l * DM * ADA_N + 32 * g;
            const int kk = lane >> 5, col = lane & 31; float a0 = 0.f, a1 = 0.f, a2 = 0.f;
#pragma unroll 8
            for (int i = 0; i < 128; ++i) { const int k = 256 * wave + 2 * i + kk; const float w = __builtin_nontemporal_load(W + (size_t)k * ADA_N + col); a0 += sv[k] * w; a1 += sv[DM + k] * w; a2 += sv[2 * DM + k] * w; }
            a0 += __shfl_xor(a0, 32); a1 += __shfl_xor(a1, 32); a2 += __shfl_xor(a2, 32);
            if (lane < 32) { red[(wave * 3 + 0) * 32 + col] = a0; red[(wave * 3 + 1) * 32 + col] = a1; red[(wave * 3 + 2) * 32 + col] = a2; }
            __syncthreads();
            if (tid < 96) { const int r = tid / 32, c = tid % 32; float s = 0.f;
#pragma unroll
                for (int w = 0; w < 8; ++w) s += red[(w * 3 + r) * 32 + c];
                ADA[(size_t)(l * 3 + r) * ADA_N + 32 * g + c] = s + args.in[I_BADA][l * ADA_N + 32 * g + c]; }
            __syncthreads();
        }
        if (bx == 0) {
            for (int i = tid; i < 2048; i += 512) { const int pos = i >> 4, f = i & 15;
                const double inv = exp(-(double)f * (9.210340371976182736071965818737 / 16.0));
                const float invf = (float)inv; const float ang = (float)pos * invf;
                float c, s; sincos_d((double)ang, c, s); ROPE[i] = c; ROPE[2048 + i] = s; }
            if (wave == 0) {
                for (int l = 0; l < 2; ++l) {
                    const float p1 = wave_sum(args.in[I_LQ1][l * 64 + lane] * args.in[I_LK1][l * 64 + lane]);
                    const float p2 = wave_sum(args.in[I_LQ2][l * 64 + lane] * args.in[I_LK2][l * 64 + lane]);
                    const float lam_init = l == 0 ? 0.2f : (float)(0.8 - 0.6 * 0.74081822068171786607);
                    if (lane == 0) LAM[l] = expf(p1) - expf(p2) + lam_init;
                }
            }
        }
        __syncthreads();
        {
            CArgs ap0 = (CArgs)__builtin_amdgcn_kernarg_segment_ptr();
            unsigned* wq = (unsigned*)(ws + WS_CTL) + 8192;
            LAS int* nxt = (LAS int*)(lds + 8 * 16640 + 2048 + 256);
            for (;;) {
                if (tid == 0) nxt[0] = (int)atomicAdd(wq, 1u);
                __syncthreads();
                const int st = nxt[0];
                __syncthreads();
                if (st >= NSA) break;
                do_strip_A(ap0, st, lds, tid);
            }
        }
        SEAM(PH_P0);
    }

    run_layer<0>(lds, bar, lo, hi, G, bx, vcu);
    run_layer<1>(lds, bar, lo, hi, G, bx, vcu);
#undef IN
#undef SEAM
}

extern "C" void kernel_launch(void* const* d_in, const int* in_sizes, int n_in, void* d_out, int out_size, void* d_ws, size_t ws_size, hipStream_t stream) {
    static int grid = 0;
    if (grid == 0) {
        if (n_in != 28 || in_sizes[0] != NTOK * DM || out_size != NTOK * DM || ws_size < WS_END) {
            fprintf(stderr, "kernel_launch: shape/workspace mismatch: n_in %d in0 %d out %d ws %zu (need %zu); nothing launched\n", n_in, n_in > 0 ? in_sizes[0] : -1, out_size, ws_size, (size_t)WS_END);
            grid = -1; return; }
        int dev = 0, cus = 0, per_cu = 0;
        if (hipGetDevice(&dev) != hipSuccess || hipDeviceGetAttribute(&cus, hipDeviceAttributeMultiprocessorCount, dev) != hipSuccess) { grid = -1; return; }
        if (hipFuncSetAttribute((const void*)fwd, hipFuncAttributeMaxDynamicSharedMemorySize, LDS_BYTES) != hipSuccess) { fprintf(stderr, "kernel_launch: hipFuncSetAttribute failed\n"); grid = -1; return; }
        if (hipOccupancyMaxActiveBlocksPerMultiprocessor(&per_cu, (const void*)fwd, 512, LDS_BYTES) != hipSuccess || per_cu < 1)
            fprintf(stderr, "kernel_launch: occupancy query reports %d workgroups per CU\n", per_cu);
        (void)hipGetLastError();
        grid = cus;
    }
    if (grid < 0) return;
    (void)hipMemsetAsync((char*)d_ws + WS_CTL, 0, CTL_ZERO_BYTES, stream);
    Args a{};
    for (int i = 0; i < 28; ++i) a.in[i] = (const float*)d_in[i];
    a.out = (float*)d_out; a.ws = (unsigned char*)d_ws;
#if MK_MULTI
    for (int p = 0; p < PH_END; ++p) { if (!phase_valid(p)) continue; a.ph_lo = p; a.ph_hi = p + 1; hipLaunchKernelGGL(fwd, dim3(grid), dim3(512), LDS_BYTES, stream, a); }
#else
    a.ph_lo = 0; a.ph_hi = PH_END;
    hipLaunchKernelGGL(fwd, dim3(grid), dim3(512), LDS_BYTES, stream, a);
#endif
    const hipError_t le = hipPeekAtLastError();
    if (le != hipSuccess) fprintf(stderr, "kernel_launch: launch failed: %s\n", hipGetErrorName(le));
}
```
